# Optimizing an MI355X kernel written in HIP

```python
import jax, jax.numpy as jnp
from jax import lax
import numpy as np

D_MODEL = 2048
BATCH = 16
SEQ = 256
DEPTH = 1
DEC_BATCH = 4
DEC_SEQ = 4096
PAST_LEN = 512

GRID_W = 64
HEAD_DIM = 128
N_Q_HEADS = 8
N_KV_HEADS = 2
Q_PER_KV = N_Q_HEADS // N_KV_HEADS
ATTN_WIDTH = N_Q_HEADS * HEAD_DIM
KV_WIDTH = N_KV_HEADS * HEAD_DIM
POOL_WINDOWS = (2, 4, 8, 16)
N_POOL_GROUPS = len(POOL_WINDOWS)
POOL_WIDTH = D_MODEL - ATTN_WIDTH
POOL_GROUP_WIDTH = POOL_WIDTH // N_POOL_GROUPS
MIX_WIDTH = ATTN_WIDTH + POOL_WIDTH
IN_WIDTH = ATTN_WIDTH + 2 * KV_WIDTH + POOL_WIDTH
D_FF = 4 * D_MODEL
Q_BLOCK = 128
ROPE_THETA = 10000.0
ROPE_QUARTER = HEAD_DIM // 4
EPS = 1e-6
N_MOD = 6
DEEPNORM_ALPHA = (2.0 * DEPTH) ** 0.25
DEEPNORM_BETA = (8.0 * DEPTH) ** -0.25

kernel_name = "hybrid_pool_gqa_prefix_diffusion_step"


def _layer_norm(x):
    xf = x.astype(jnp.float32)
    mu = jnp.mean(xf, axis=-1, keepdims=True)
    var = jnp.mean(jnp.square(xf - mu), axis=-1, keepdims=True)
    return (xf - mu) * lax.rsqrt(var + EPS)


def _rms_norm(x, gain):
    xf = x.astype(jnp.float32)
    return xf * lax.rsqrt(jnp.mean(jnp.square(xf), axis=-1, keepdims=True) + EPS) * gain.astype(jnp.float32)


def _rotate(x, cos, sin):
    x1, x2 = jnp.split(x, 2, axis=-1)
    return jnp.concatenate([x1 * cos - x2 * sin, x2 * cos + x1 * sin], axis=-1)


def _apply_rope(x, rope):
    cos_r, sin_r, cos_c, sin_c = rope
    xr, xc = jnp.split(x.astype(jnp.float32), 2, axis=-1)
    return jnp.concatenate([_rotate(xr, cos_r, sin_r), _rotate(xc, cos_c, sin_c)], axis=-1)


def _grid_rope(n_tokens):
    n_rows = n_tokens // GRID_W
    row = jnp.repeat(jnp.arange(n_rows, dtype=jnp.float32), GRID_W)
    col = jnp.tile(jnp.arange(GRID_W, dtype=jnp.float32), n_rows)
    inv_freq = ROPE_THETA ** (-(jnp.arange(ROPE_QUARTER, dtype=jnp.float32) / ROPE_QUARTER))
    ang_r = (row[:, None] * inv_freq)[:, None, :]
    ang_c = (col[:, None] * inv_freq)[:, None, :]
    return (jnp.cos(ang_r), jnp.sin(ang_r), jnp.cos(ang_c), jnp.sin(ang_c))


def _block_attention(q, k, v):
    b, t = q.shape[0], q.shape[1]
    nb = t // Q_BLOCK
    qb = q.reshape(b, nb, Q_BLOCK, N_KV_HEADS, Q_PER_KV, HEAD_DIM).transpose(1, 0, 2, 3, 4, 5)
    kf = k.astype(jnp.float32)
    vf = v.astype(jnp.float32)
    scale = HEAD_DIM ** -0.5

    def one_block(q_blk):
        s = jnp.einsum('bqkgd,bskd->bkgqs', q_blk.astype(jnp.float32), kf) * scale
        p = jax.nn.softmax(s, axis=-1)
        return jnp.einsum('bkgqs,bskd->bqkgd', p, vf)

    out = lax.map(one_block, qb)
    return out.transpose(1, 0, 2, 3, 4, 5).reshape(b, t, ATTN_WIDTH)


def _pool_mixer(p, w_pool, pool_scale):
    b, t, _ = p.shape
    pg = p.reshape(b, t, N_POOL_GROUPS, POOL_GROUP_WIDTH).astype(jnp.float32)
    csum = jnp.concatenate([jnp.zeros((b, 1, N_POOL_GROUPS, POOL_GROUP_WIDTH), jnp.float32),
                            jnp.cumsum(pg, axis=1)], axis=1)
    pos = jnp.arange(t)
    outs = []
    for g, w in enumerate(POOL_WINDOWS):
        lo = jnp.clip(pos - w // 2, 0, t)
        hi = jnp.clip(pos + w // 2, 0, t)
        cg = csum[:, :, g]
        s = jnp.take(cg, hi, axis=1) - jnp.take(cg, lo, axis=1)
        cnt = (hi - lo).astype(jnp.float32)[None, :, None]
        outs.append(s / cnt - pg[:, :, g])
    pooled = jnp.stack(outs, axis=2)
    mixed = jnp.einsum('btgc,gce->btge', pooled, w_pool.astype(jnp.float32))
    return (mixed.reshape(b, t, POOL_WIDTH) * pool_scale.astype(jnp.float32)).astype(p.dtype)


def _layer(x, mod, w_in, q_gain, k_gain, w_pool, pool_scale, w_out,
           ln1_g, ln1_b, w_ff1, w_ff2, ln2_g, ln2_b, rope=None, k_ctx=None, v_ctx=None):
    dt = x.dtype
    b, t, _ = x.shape
    shift1, scale1, gate1 = mod[:, None, 0], mod[:, None, 1], mod[:, None, 2]
    shift2, scale2, gate2 = mod[:, None, 3], mod[:, None, 4], mod[:, None, 5]

    u = (_layer_norm(x) * (1.0 + scale1) + shift1).astype(dt)
    proj = jnp.einsum('btd,de->bte', u, w_in)
    q_raw, k_raw, v_raw, p = jnp.split(proj, [ATTN_WIDTH, ATTN_WIDTH + KV_WIDTH, ATTN_WIDTH + 2 * KV_WIDTH], axis=-1)
    q = _rms_norm(q_raw.reshape(b, t, N_Q_HEADS, HEAD_DIM), q_gain)
    k = _rms_norm(k_raw.reshape(b, t, N_KV_HEADS, HEAD_DIM), k_gain)
    v = v_raw.reshape(b, t, N_KV_HEADS, HEAD_DIM)
    if rope is not None:
        q = _apply_rope(q, rope)
        k = _apply_rope(k, rope)
    q = q.astype(dt)
    k = k.astype(dt)
    if k_ctx is not None:
        keys = jnp.concatenate([k_ctx.astype(dt), k], axis=1)
        vals = jnp.concatenate([v_ctx.astype(dt), v], axis=1)
    else:
        keys, vals = k, v
    attn = _block_attention(q, keys, vals).astype(dt)
    pool = _pool_mixer(p, w_pool, pool_scale)
    mix = jnp.einsum('bte,ed->btd', jnp.concatenate([attn, pool], axis=-1), w_out)
    x1 = (_layer_norm(DEEPNORM_ALPHA * x + gate1 * mix) * ln1_g + ln1_b).astype(dt)

    u2 = (_layer_norm(x1) * (1.0 + scale2) + shift2).astype(dt)
    h = jnp.square(jax.nn.relu(jnp.einsum('btd,df->btf', u2, w_ff1)))
    f = jnp.einsum('btf,fd->btd', h, w_ff2)
    x2 = (_layer_norm(DEEPNORM_ALPHA * x1 + gate2 * f) * ln2_g + ln2_b).astype(dt)
    return x2, k, v


def setup_inputs(seed: int = 0) -> dict:
    key = jax.random.key(seed)
    ks = jax.random.split(key, 24)
    f32 = jnp.float32
    nrm = lambda k, s: jax.random.normal(k, s, f32)
    return {
        "x_prompt": nrm(ks[0], (BATCH, SEQ, D_MODEL)),
        "x_sample": nrm(ks[1], (DEC_BATCH, DEC_SEQ, D_MODEL)),
        "cache_k": nrm(ks[2], (DEC_BATCH, DEPTH, PAST_LEN, N_KV_HEADS, HEAD_DIM)),
        "cache_v": nrm(ks[3], (DEC_BATCH, DEPTH, PAST_LEN, N_KV_HEADS, HEAD_DIM)),
        "c": nrm(ks[4], (DEC_BATCH, D_MODEL)),
        "c_ctx": nrm(ks[5], (D_MODEL,)),
        "w_mod": nrm(ks[6], (DEPTH, D_MODEL, N_MOD * D_MODEL)) * (0.5 * D_MODEL ** -0.5),
        "b_mod": nrm(ks[7], (DEPTH, N_MOD * D_MODEL)) * 0.02,
        "w_in": nrm(ks[8], (DEPTH, D_MODEL, IN_WIDTH)) * D_MODEL ** -0.5,
        "q_gain": 1.0 + 0.1 * nrm(ks[9], (DEPTH, HEAD_DIM)),
        "k_gain": 1.0 + 0.1 * nrm(ks[10], (DEPTH, HEAD_DIM)),
        "w_pool": nrm(ks[11], (DEPTH, N_POOL_GROUPS, POOL_GROUP_WIDTH, POOL_GROUP_WIDTH)) * POOL_GROUP_WIDTH ** -0.5,
        "pool_scale": 1.0 + 0.1 * nrm(ks[12], (DEPTH, POOL_WIDTH)),
        "w_out": nrm(ks[13], (DEPTH, MIX_WIDTH, D_MODEL)) * (MIX_WIDTH ** -0.5 * DEEPNORM_BETA),
        "ln1_g": 1.0 + 0.1 * nrm(ks[14], (DEPTH, D_MODEL)),
        "ln1_b": 0.02 * nrm(ks[15], (DEPTH, D_MODEL)),
        "w_ff1": nrm(ks[16], (DEPTH, D_MODEL, D_FF)) * D_MODEL ** -0.5,
        "w_ff2": nrm(ks[17], (DEPTH, D_FF, D_MODEL)) * (D_FF ** -0.5 * DEEPNORM_BETA),
        "ln2_g": 1.0 + 0.1 * nrm(ks[18], (DEPTH, D_MODEL)),
        "ln2_b": 0.02 * nrm(ks[19], (DEPTH, D_MODEL)),
    }


def reference(x_prompt, x_sample, cache_k, cache_v, c, c_ctx, w_mod, b_mod, w_in, q_gain, k_gain,
              w_pool, pool_scale, w_out, ln1_g, ln1_b, w_ff1, w_ff2, ln2_g, ln2_b):
    rope = _grid_rope(x_sample.shape[1])
    h_ctx = x_prompt
    h_lat = x_sample
    new_k, new_v = [], []
    for l in range(DEPTH):
        mod_ctx = (jax.nn.silu(c_ctx) @ w_mod[l] + b_mod[l]).reshape(1, N_MOD, D_MODEL)
        mod_lat = (jax.nn.silu(c) @ w_mod[l] + b_mod[l]).reshape(c.shape[0], N_MOD, D_MODEL)
        lw = (w_in[l], q_gain[l], k_gain[l], w_pool[l], pool_scale[l], w_out[l],
              ln1_g[l], ln1_b[l], w_ff1[l], w_ff2[l], ln2_g[l], ln2_b[l])
        h_ctx, k_c, v_c = _layer(h_ctx, mod_ctx, *lw)
        new_k.append(k_c)
        new_v.append(v_c)
        h_lat, _, _ = _layer(h_lat, mod_lat, *lw, rope=rope,
                             k_ctx=cache_k[:, l], v_ctx=cache_v[:, l])
    ctx_k = jnp.stack(new_k, axis=1)
    ctx_v = jnp.stack(new_v, axis=1)
    return (h_ctx, h_lat, ctx_k, ctx_v)
```

```cpp
#include <hip/hip_runtime.h>
#include <hip/hip_bf16.h>
#include <hip/hip_cooperative_groups.h>
#include <cstdio>
#include <cstdint>
namespace cg = cooperative_groups;

constexpr int DM = 2048, MCTX = 4096, MLAT = 16384, MTOT = 20480, NIN = 2560, DFF = 8192, SKV_LAT = 4608, NMOD = 12288;
constexpr float LN_EPS = 1e-6f, ALPHA = 1.189207115002721f;
constexpr size_t al256(size_t x) { return (x + 255) / 256 * 256; }
constexpr size_t WS_WIN = 0;
constexpr size_t WS_WOUT = WS_WIN + (size_t)NIN * DM * 2;
constexpr size_t WS_WFF1 = WS_WOUT + (size_t)DM * DM * 2;
constexpr size_t WS_WFF2 = WS_WFF1 + (size_t)DFF * DM * 2;
constexpr size_t WS_WPOOL = WS_WFF2 + (size_t)DFF * DM * 2;
constexpr size_t WS_MOD = WS_WPOOL + (size_t)1024 * 256 * 2;
constexpr size_t WS_ACT = WS_MOD + al256((size_t)5 * NMOD * 4);
constexpr size_t WS_BIG = WS_ACT + (size_t)MTOT * DM * 2;
constexpr size_t WS_PROJ = WS_BIG;
constexpr size_t WS_Q = WS_PROJ + (size_t)MTOT * NIN * 2;
constexpr size_t WS_KLAT = WS_Q + (size_t)MTOT * 1024 * 2;
constexpr size_t WS_VLAT = WS_KLAT + (size_t)4 * SKV_LAT * 256 * 2;
constexpr size_t WS_KCTX = WS_VLAT + (size_t)4 * SKV_LAT * 256 * 2;
constexpr size_t WS_VCTX = WS_KCTX + (size_t)MCTX * 256 * 2;
constexpr size_t WS_POOLED = WS_VCTX + (size_t)MCTX * 256 * 2;
constexpr size_t WS_BIG_END1 = WS_POOLED + (size_t)MTOT * 1024 * 2;
constexpr size_t WS_H = WS_BIG;
constexpr size_t WS_END = WS_H + (size_t)MTOT * DFF * 2;
static_assert(WS_BIG_END1 <= WS_END, "aliasing");
constexpr int LDS_BYTES = 131072;

namespace pg8 {
#define PG8_LAS __attribute__((address_space(3)))
typedef unsigned short bf16_t;
typedef short bf16x8 __attribute__((ext_vector_type(8)));
typedef float f32x4 __attribute__((ext_vector_type(4)));
typedef unsigned u32x4 __attribute__((ext_vector_type(4)));
constexpr int BM = 256, BK = 64, HALF = 128, HTB = HALF * BK * 2  , STAGE_BYTES = 8 * HTB, NXCD = 8, WGM = 8;

__host__ __device__ __forceinline__ int lds_byte(int r, int c) { const int st = (r >> 4) * 2 + (c >> 5), rr = r & 15, cc = c & 31, ob = rr * 64 + cc * 2; return st * 1024 + (ob ^ (((ob >> 9) & 1) << 5)); }
__host__ __device__ __forceinline__ void stage_rc(int b, int& R, int& C) { const int st = b / 1024, sb = b % 1024, swz = sb ^ (((sb >> 9) & 1) << 5); R = (st >> 1) * 16 + swz / 64; C = (st & 1) * 32 + (swz % 64) / 2; }
__host__ __device__ __forceinline__ int perm32(int rho) { const int n = rho >> 4, i = rho & 15; return 8 * (i >> 2) + 4 * n + (i & 3); }

struct Unit { int pm, pn; };
struct Gemm { const bf16_t* A; const bf16_t* Bt; int M, N, K, lda, ldb, a_pn_off; };

struct StaticOrder {
    int nM, nN, nwg, G, c;
    __host__ __device__ void init(int M, int N, int G_, int c_) { nM = M / BM; nN = N / BM; nwg = nM * nN; G = G_; c = c_; }
    __host__ __device__ bool next(int i, Unit& u) const {
        const long L = (long)i * G + c; if (L >= nwg) return false;
        int wgid = (int)L; { const int q = nwg / NXCD, r = nwg % NXCD, xcd = wgid % NXCD, off = wgid / NXCD; wgid = (xcd < r ? xcd * (q + 1) : r * (q + 1) + (xcd - r) * q) + off; }
        const int nig = WGM * nN, gid = wgid / nig, fm = gid * WGM, gsz = (nM - fm) < WGM ? (nM - fm) : WGM;
        u.pm = fm + ((wgid % nig) % gsz); u.pn = (wgid % nig) / gsz; return true;
    }
    __device__ __forceinline__ void a_ready(const Unit&) const {}
    __device__ __forceinline__ void done(const Unit&) const {}
};
__device__ __forceinline__ unsigned cvt_pk_bf16(float lo, float hi) { unsigned r; asm volatile("v_cvt_pk_bf16_f32 %0, %1, %2" : "=v"(r) : "v"(lo), "v"(hi)); return r; }
template <class Epi, class Sched, bool STAMP = false>
__device__ __forceinline__ void gemm_phase(PG8_LAS unsigned char* lds, const Gemm g, const Sched& S, const Epi& E, unsigned long long* stamps) {
    int tid_l = threadIdx.x; asm volatile("" : "+v"(tid_l));
    const int tid = tid_l, wid = __builtin_amdgcn_readfirstlane(tid >> 6), lane = tid & 63, wr = wid >> 2, wc = wid & 3, fr = lane & 15, fq = lane >> 4;
    const int K = g.K, nt = K / BK;
    int ts_lo = 0, ts_hi = 0, nts = 0; const unsigned long long rt_entry = STAMP ? (unsigned long long)wall_clock64() : 0ull;
#define PG8_STAMP() do { if (STAMP && wid == 0 && nts < 64) { const unsigned long long _c = (unsigned long long)clock64(); \
        ts_lo = (lane == nts) ? (int)(unsigned)_c : ts_lo; ts_hi = (lane == nts) ? (int)(unsigned)(_c >> 32) : ts_hi; ++nts; } } while (0)
    PG8_STAMP();
    unsigned voffA[2], voffB[2];
#pragma unroll
    for (int i = 0; i < 2; ++i) { int R, C; stage_rc(tid * 16 + i * 8192, R, C); const int Rb = Epi::PERM ? ((R & ~31) + perm32(R & 31)) : R;
        voffA[i] = (unsigned)(R * g.lda + C) * 2u; voffB[i] = (unsigned)(Rb * g.ldb + C) * 2u; }
    const size_t kstep = (size_t)(BK * 2);
    const size_t hstepA = (size_t)HALF * g.lda * 2, hstepB = (size_t)HALF * g.ldb * 2;
    const size_t tstepA = 2 * hstepA, tstepB = 2 * hstepB;
    const unsigned ldsw = (unsigned)wid * 1024u;
    const int aoff = lds_byte(wr * 64 + fr, fq * 8), boff = lds_byte(wc * 32 + fr, fq * 8);
#define PG8_SA(b, h) (((b) * 2 + (h)) * HTB)
#define PG8_SB(b, h) ((4 + (b) * 2 + (h)) * HTB)
#define PG8_STAGE(bufoff, gbase, voff) do { _Pragma("unroll") for (int _i = 0; _i < 2; ++_i) \
        __builtin_amdgcn_global_load_lds((const unsigned*)((const char*)(gbase) + (voff)[_i]), (PG8_LAS unsigned*)(lds + (bufoff) + ldsw + _i * 8192), 16, 0, 0); } while (0)
#define PG8_LDA(dst, b, h) do { _Pragma("unroll") for (int m = 0; m < 4; ++m) _Pragma("unroll") for (int k = 0; k < 2; ++k) dst[m][k] = *(const PG8_LAS bf16x8*)(lds + PG8_SA(b, h) + aoff + m * 2048 + k * 1024); } while (0)
#define PG8_LDB(dst, b, h) do { _Pragma("unroll") for (int n = 0; n < 2; ++n) _Pragma("unroll") for (int k = 0; k < 2; ++k) dst[n][k] = *(const PG8_LAS bf16x8*)(lds + PG8_SB(b, h) + boff + n * 2048 + k * 1024); } while (0)
#define PG8_MMA(ai, bj, At, Bt) do { __builtin_amdgcn_s_setprio(1); _Pragma("unroll") for (int m = 0; m < 4; ++m) _Pragma("unroll") for (int n = 0; n < 2; ++n) _Pragma("unroll") for (int k = 0; k < 2; ++k) \
        acc[ai][bj][m][n] = __builtin_amdgcn_mfma_f32_16x16x32_bf16(Bt[n][k], At[m][k], acc[ai][bj][m][n], 0, 0, 0); __builtin_amdgcn_s_setprio(0); } while (0)
#define PG8_WAIT_V(n) asm volatile("s_waitcnt vmcnt(" #n ")" ::: "memory")
#define PG8_WAIT_L(n) asm volatile("s_waitcnt lgkmcnt(" #n ")" ::: "memory")
#define PG8_BAR __builtin_amdgcn_s_barrier()
#define PG8_SCHED __builtin_amdgcn_sched_barrier(0)
    Unit cur, nxt; int ui = 0;
    if (!S.next(0, cur)) return;
    f32x4 acc[2][2][4][2];
#pragma unroll
    for (int a = 0; a < 2; ++a)
#pragma unroll
        for (int b = 0; b < 2; ++b)
#pragma unroll
            for (int m = 0; m < 4; ++m)
#pragma unroll
                for (int n = 0; n < 2; ++n) acc[a][b][m][n] = (f32x4){0.f, 0.f, 0.f, 0.f};
    bf16x8 At[4][2], B0[2][2], B1[2][2];
    const char* cA = (const char*)g.A + (size_t)cur.pm * tstepA + (size_t)cur.pn * g.a_pn_off; const char* cB = (const char*)g.Bt + (size_t)cur.pn * tstepB;
    S.a_ready(cur);
    PG8_STAGE(PG8_SB(0, 0), cB, voffB); PG8_STAGE(PG8_SA(0, 0), cA, voffA); PG8_STAGE(PG8_SB(0, 1), cB + hstepB, voffB); PG8_STAGE(PG8_SA(0, 1), cA + hstepA, voffA);
    if (wr == 1) PG8_BAR;
    PG8_WAIT_V(4); PG8_BAR;
    PG8_STAGE(PG8_SB(1, 0), cB + kstep, voffB); PG8_STAGE(PG8_SA(1, 0), cA + kstep, voffA); PG8_STAGE(PG8_SB(1, 1), cB + hstepB + kstep, voffB);
    PG8_WAIT_V(6); PG8_BAR;
    PG8_STAMP();
    for (;;) {
        const bool has_next = S.next(ui + 1, nxt);
        const char* nA = has_next ? (const char*)g.A + (size_t)nxt.pm * tstepA + (size_t)nxt.pn * g.a_pn_off : cA; const char* nB = has_next ? (const char*)g.Bt + (size_t)nxt.pn * tstepB : cB;
        for (int t = 0; t < nt; t += 2) {
            const bool last = (t == nt - 2);
            const char* a1 = cA + (size_t)(t + 1) * kstep;
            const char* a2 = last ? nA : cA + (size_t)(t + 2) * kstep; const char* b2 = last ? nB : cB + (size_t)(t + 2) * kstep;
            const char* a3 = a2 + kstep; const char* b3 = b2 + kstep;
            if (last && has_next) S.a_ready(nxt);
            PG8_LDB(B0, 0, 0); PG8_SCHED; PG8_LDA(At, 0, 0); PG8_STAGE(PG8_SA(1, 1), a1 + hstepA, voffA);
            PG8_WAIT_L(8); PG8_BAR; PG8_WAIT_L(0); PG8_MMA(0, 0, At, B0); PG8_BAR; PG8_SCHED;
            PG8_LDB(B1, 0, 1); PG8_STAGE(PG8_SB(0, 0), b2, voffB);
            PG8_BAR; PG8_WAIT_L(0); PG8_MMA(0, 1, At, B1); PG8_BAR;
            PG8_LDA(At, 0, 1); PG8_STAGE(PG8_SA(0, 0), a2, voffA);
            PG8_BAR; PG8_WAIT_L(0); PG8_MMA(1, 0, At, B0); PG8_BAR; PG8_SCHED;
            PG8_STAGE(PG8_SB(0, 1), b2 + hstepB, voffB);
            PG8_WAIT_V(6); PG8_BAR; PG8_MMA(1, 1, At, B1); PG8_BAR;
            PG8_LDB(B0, 1, 0); PG8_SCHED; PG8_LDA(At, 1, 0); PG8_STAGE(PG8_SA(0, 1), a2 + hstepA, voffA);
            PG8_WAIT_L(8); PG8_BAR; PG8_WAIT_L(0); PG8_MMA(0, 0, At, B0); PG8_BAR; PG8_SCHED;
            PG8_LDB(B1, 1, 1); PG8_STAGE(PG8_SB(1, 0), b3, voffB);
            PG8_BAR; PG8_WAIT_L(0); PG8_MMA(0, 1, At, B1); PG8_BAR;
            PG8_LDA(At, 1, 1); PG8_STAGE(PG8_SA(1, 0), a3, voffA);
            PG8_BAR; PG8_WAIT_L(0); PG8_MMA(1, 0, At, B0); PG8_BAR; PG8_SCHED;
            PG8_STAGE(PG8_SB(1, 1), b3 + hstepB, voffB);
            PG8_WAIT_V(6); PG8_BAR; PG8_MMA(1, 1, At, B1); PG8_BAR;
        }
        PG8_STAMP();
        if constexpr (!Epi::AFTER_DRAIN) { E(acc, cur, wr, wc, fr, fq); S.done(cur); }
        PG8_STAMP();
        if (!has_next) break;
#pragma unroll
        for (int a = 0; a < 2; ++a)
#pragma unroll
            for (int b = 0; b < 2; ++b)
#pragma unroll
                for (int m = 0; m < 4; ++m)
#pragma unroll
                    for (int n = 0; n < 2; ++n) acc[a][b][m][n] = (f32x4){0.f, 0.f, 0.f, 0.f};
        cur = nxt; cA = nA; cB = nB; ++ui;
    }
    PG8_WAIT_V(0);
    if (wr == 0) PG8_BAR;
    PG8_BAR;
    if constexpr (Epi::AFTER_DRAIN) { E.fused(acc, cur, wr, wc, fr, fq, lds, wid, lane); S.done(cur); }
    PG8_STAMP();
    if (STAMP && wid == 0) { stamps[lane] = lane < nts ? (((unsigned long long)(unsigned)ts_hi << 32) | (unsigned)ts_lo) : 0ull;
        if (lane == 62) stamps[62] = rt_entry; if (lane == 63) stamps[63] = (unsigned long long)wall_clock64(); }
#undef PG8_STAMP
#undef PG8_SA
#undef PG8_SB
#undef PG8_STAGE
#undef PG8_LDA
#undef PG8_LDB
#undef PG8_MMA
#undef PG8_WAIT_V
#undef PG8_WAIT_L
#undef PG8_BAR
#undef PG8_SCHED
}
}
namespace att {
using bf16 = __hip_bfloat16;
constexpr int   D = 128, NW = 8, QBLK = 32, KVBLK = 64;
constexpr float SCALE = 0.088388347648318440f;
constexpr float THR = 8.f;
#ifndef ATT_SDEPTH
#define ATT_SDEPTH 2
#endif
constexpr int SDEPTH = ATT_SDEPTH;
constexpr int LDQ = 1024, LDK = 256, LDO = 2048;
constexpr size_t SHM_V = KVBLK * D * 2, SHM_K = KVBLK * D * 2, SHM_ATTN = 2 * SHM_V + 2 * SHM_K + NW * 64 * 4;
using bf16x8 = __attribute__((ext_vector_type(8))) short;
using s16x4  = __attribute__((ext_vector_type(4))) short;
using f32x16 = __attribute__((ext_vector_type(16))) float;
using f32x8  = __attribute__((ext_vector_type(8))) float;
using u32x4  = __attribute__((ext_vector_type(4))) unsigned;
#define KSWZ(row, colB) ((row) * 256 + ((colB) ^ (((row) & 7) << 4)))
#define SBAR() __builtin_amdgcn_sched_barrier(0)
__device__ __forceinline__ int crow(int r, int hi) { return (r & 3) + 8 * (r >> 2) + 4 * hi; }
__device__ __forceinline__ unsigned cvtpk(float lo, float hi) {
  unsigned r; asm volatile("v_cvt_pk_bf16_f32 %0, %1, %2" : "=v"(r) : "v"(lo), "v"(hi)); return r;
}
template <typename TIn> struct Stage;
template <> struct Stage<bf16>  { using T = bf16x8;
  __device__ static __forceinline__ T ld8(const bf16* p) { return *reinterpret_cast<const bf16x8*>(p); }
  __device__ static __forceinline__ bf16x8 tobf(T x) { return x; } };
template <> struct Stage<float> { using T = f32x8;
  __device__ static __forceinline__ T ld8(const float* p) { return *reinterpret_cast<const f32x8*>(p); }
  __device__ static __forceinline__ bf16x8 tobf(T x) {
    u32x4 w = {cvtpk(x[0], x[1]), cvtpk(x[2], x[3]), cvtpk(x[4], x[5]), cvtpk(x[6], x[7])}; return *reinterpret_cast<bf16x8*>(&w); } };

__device__ __forceinline__ void partialSM(f32x16& p0, f32x16& p1, float& m_reg, float& mn, float& alpha) {
  constexpr float C = SCALE * 1.4426950408889634f;
  float pmax = p0[0]; for (int r = 1; r < 16; ++r) pmax = fmaxf(pmax, p0[r]); for (int r = 0; r < 16; ++r) pmax = fmaxf(pmax, p1[r]);
  { auto rr = __builtin_amdgcn_permlane32_swap(__float_as_uint(pmax), __float_as_uint(pmax), false, false);
    pmax = fmaxf(__uint_as_float(rr[0]), __uint_as_float(rr[1])); }
  if (__builtin_expect(__all(pmax - m_reg <= THR / SCALE), 1)) { mn = m_reg; alpha = 1.f; }
  else { mn = fmaxf(m_reg, pmax); alpha = __builtin_amdgcn_exp2f((m_reg - mn) * C); m_reg = mn; }
  float mnC = -mn * C;
  for (int r = 0; r < 16; ++r) p0[r] = fmaf(p0[r], C, mnC); for (int r = 0; r < 16; ++r) p1[r] = fmaf(p1[r], C, mnC);
  for (int r = 0; r < 16; ++r) p0[r] = __builtin_amdgcn_exp2f(p0[r]);
}
__device__ __forceinline__ void finishSM(f32x16& p0, f32x16& p1, float alpha, float& l_reg, bf16x8& pa0, bf16x8& pa1, bf16x8& pa2, bf16x8& pa3) {
  for (int r = 0; r < 16; ++r) p1[r] = __builtin_amdgcn_exp2f(p1[r]);
  float ps = 0; for (int r = 0; r < 16; ++r) ps += p0[r]; for (int r = 0; r < 16; ++r) ps += p1[r];
  { auto rr = __builtin_amdgcn_permlane32_swap(__float_as_uint(ps), __float_as_uint(ps), false, false);
    ps = __uint_as_float(rr[0]) + __uint_as_float(rr[1]); }
  l_reg = l_reg * alpha + ps;
#define PK4(P, BASE, OUT) do { unsigned a0 = cvtpk(P[BASE + 0], P[BASE + 1]), a1 = cvtpk(P[BASE + 2], P[BASE + 3]);   \
    unsigned b0 = cvtpk(P[BASE + 4], P[BASE + 5]), b1 = cvtpk(P[BASE + 6], P[BASE + 7]);                              \
    auto r0 = __builtin_amdgcn_permlane32_swap(a0, b0, false, false); auto r1 = __builtin_amdgcn_permlane32_swap(a1, b1, false, false); \
    u32x4 w = {r0[0], r1[0], r0[1], r1[1]}; OUT = *reinterpret_cast<bf16x8*>(&w); } while (0)
  PK4(p0, 0, pa0); PK4(p0, 8, pa1); PK4(p1, 0, pa2); PK4(p1, 8, pa3);
#undef PK4
}
__device__ __forceinline__ void qkt(f32x16& p0, f32x16& p1, const bf16* Ks, const bf16x8* qr, int r32, int hi) {
  p0 = f32x16{}; p1 = f32x16{};
  for (int d0 = 0; d0 < 8; ++d0) { int cb = (d0 * 16 + hi * 8) * 2;
    bf16x8 b0 = *reinterpret_cast<const bf16x8*>((const char*)Ks + KSWZ(r32, cb));
    bf16x8 b1 = *reinterpret_cast<const bf16x8*>((const char*)Ks + KSWZ(32 + r32, cb));
    p0 = __builtin_amdgcn_mfma_f32_32x32x16_bf16(b0, qr[d0], p0, 0, 0, 0);
    p1 = __builtin_amdgcn_mfma_f32_32x32x16_bf16(b1, qr[d0], p1, 0, 0, 0); }
}
__device__ __forceinline__ int v_st(int k, int c) { const int kk = (k & ~0xC) | ((k & 4) << 1) | ((k & 8) >> 1); return ((kk >> 3) * 4 + (c >> 5)) * 512 + ((kk & 7) * 32 + (c & 31)) * 2; }
__device__ __forceinline__ int v_rd_base(int lane) { return ((lane & 3) << 3) | (((lane >> 2) & 3) << 6) | (((lane >> 4) & 1) << 5) | (((lane >> 5) & 1) << 8); }
constexpr int v_rd_off(int d0, int ks, int half) { return d0 * 512 + ks * 4096 + half * 2048; }
template <int OFF> __device__ __forceinline__ s16x4 tr_read(int vb) {
  s16x4 r; asm volatile("ds_read_b64_tr_b16 %0, %1 offset:%2" : "=&v"(r) : "v"(vb), "i"(OFF) : "memory"); return r;
}
template <int D0> __device__ __forceinline__ void pv_one(f32x16& od, int vb, bf16x8 pa0, bf16x8 pa1, bf16x8 pa2, bf16x8 pa3) {
  const s16x4 l0 = tr_read<v_rd_off(D0, 0, 0)>(vb), h0 = tr_read<v_rd_off(D0, 0, 1)>(vb), l1 = tr_read<v_rd_off(D0, 1, 0)>(vb), h1 = tr_read<v_rd_off(D0, 1, 1)>(vb);
  const s16x4 l2 = tr_read<v_rd_off(D0, 2, 0)>(vb), h2 = tr_read<v_rd_off(D0, 2, 1)>(vb), l3 = tr_read<v_rd_off(D0, 3, 0)>(vb), h3 = tr_read<v_rd_off(D0, 3, 1)>(vb);
  asm volatile("s_waitcnt lgkmcnt(0)" ::: "memory"); SBAR();
#define PK(L, H) (bf16x8){L[0], L[1], L[2], L[3], H[0], H[1], H[2], H[3]}
  od = __builtin_amdgcn_mfma_f32_32x32x16_bf16(pa0, PK(l0, h0), od, 0, 0, 0);
  od = __builtin_amdgcn_mfma_f32_32x32x16_bf16(pa1, PK(l1, h1), od, 0, 0, 0);
  od = __builtin_amdgcn_mfma_f32_32x32x16_bf16(pa2, PK(l2, h2), od, 0, 0, 0);
  od = __builtin_amdgcn_mfma_f32_32x32x16_bf16(pa3, PK(l3, h3), od, 0, 0, 0);
#undef PK
}
__device__ __forceinline__ void pv_d0(f32x16* o, int vb, bf16x8 pa0, bf16x8 pa1, bf16x8 pa2, bf16x8 pa3) {
  pv_one<0>(o[0], vb, pa0, pa1, pa2, pa3); pv_one<1>(o[1], vb, pa0, pa1, pa2, pa3); pv_one<2>(o[2], vb, pa0, pa1, pa2, pa3); pv_one<3>(o[3], vb, pa0, pa1, pa2, pa3);
}

template <typename TQ>
__device__ __forceinline__ void attn_dense_body(const TQ* __restrict__ Qb, const bf16* __restrict__ Kh, const bf16* __restrict__ Vh,
                                                unsigned short* __restrict__ Ob, int seq, char* lds) {
  using St = Stage<bf16>; using SQ = Stage<TQ>;
  int tid_l = threadIdx.x; asm volatile("" : "+v"(tid_l));
  const int tid = tid_l, wid = tid >> 6, lane = tid & 63, r32 = lane & 31, hi = lane >> 5;
  bf16* V_lds = (bf16*)lds; bf16* K_lds = (bf16*)(lds + 2 * SHM_V);
  float* ws = (float*)(lds + 2 * SHM_V + 2 * SHM_K) + wid * 64; float* li_l = ws; float* al_l = ws + 32;
  float m_reg = -1e30f, l_reg = 0; f32x16 o[4] = {}; bf16x8 qr[8];
  const TQ* Qw = Qb + (long)(wid * QBLK + r32) * LDQ + hi * 8;
#pragma unroll
  for (int d0 = 0; d0 < 8; ++d0) qr[d0] = SQ::tobf(SQ::ld8(Qw + d0 * 16));
  const int sr = tid >> 4, sc = (tid & 15) * 8, vst0 = v_st(sr, sc), vst1 = v_st(32 + sr, sc);
  const int vb0 = (int)(uintptr_t)V_lds + v_rd_base(lane);
  struct { typename St::T vs0, vs1, ks0, ks1; } sr_[SDEPTH];
#define SLOAD(i, k0) do { sr_[i].vs0 = St::ld8(&Vh[(long)((k0) + sr) * LDK + sc]); sr_[i].vs1 = St::ld8(&Vh[(long)((k0) + 32 + sr) * LDK + sc]); \
    sr_[i].ks0 = St::ld8(&Kh[(long)((k0) + sr) * LDK + sc]); sr_[i].ks1 = St::ld8(&Kh[(long)((k0) + 32 + sr) * LDK + sc]); } while (0)
#define SWRITE(b, i) do { *(bf16x8*)((char*)V_lds + (b) * SHM_V + vst0) = St::tobf(sr_[i].vs0);          \
    *(bf16x8*)((char*)V_lds + (b) * SHM_V + vst1) = St::tobf(sr_[i].vs1); int kc = sc * 2;               \
    *(bf16x8*)((char*)K_lds + (b) * SHM_K + KSWZ(sr, kc)) = St::tobf(sr_[i].ks0);                       \
    *(bf16x8*)((char*)K_lds + (b) * SHM_K + KSWZ(32 + sr, kc)) = St::tobf(sr_[i].ks1); } while (0)
#define SWAIT() do { if constexpr (SDEPTH == 2) asm volatile("s_waitcnt vmcnt(4)" ::: "memory"); else asm volatile("s_waitcnt vmcnt(0)" ::: "memory"); } while (0)
#define RESC(a) do { if (__any((a) < 1.f)) { if (hi == 0) al_l[r32] = (a); asm volatile("s_waitcnt lgkmcnt(0)" ::: "memory"); \
    for (int d = 0; d < 4; ++d) for (int r = 0; r < 16; ++r) o[d][r] *= al_l[crow(r, hi)]; } } while (0)
  f32x16 pA0, pA1, pB0, pB1; float mnA, mnB, alA, alB; bf16x8 pa0, pa1, pa2, pa3; const int NT = seq / KVBLK;
  constexpr int SE = 0, SO = SDEPTH - 1;
  SLOAD(SE, 0); asm volatile("s_waitcnt vmcnt(0)" ::: "memory"); SWRITE(0, SE); __syncthreads();
  qkt(pA0, pA1, K_lds, qr, r32, hi); partialSM(pA0, pA1, m_reg, mnA, alA);
  SLOAD(SO, KVBLK); if constexpr (SDEPTH == 2) { if (2 < NT) SLOAD(SE, 2 * KVBLK); }
  SWAIT(); SWRITE(1, SO); __syncthreads();
  for (int j = 1; j + 1 < NT; j += 2) {
    SBAR(); qkt(pB0, pB1, (bf16*)((char*)K_lds + SHM_K), qr, r32, hi);
    finishSM(pA0, pA1, alA, l_reg, pa0, pa1, pa2, pa3); SBAR();
    SLOAD(SO, (j + SDEPTH) * KVBLK); SBAR();
    pv_d0(o, vb0, pa0, pa1, pa2, pa3); partialSM(pB0, pB1, m_reg, mnB, alB);
    __syncthreads(); SWAIT(); SWRITE(0, SE);
    RESC(alB); __syncthreads();
    SBAR(); qkt(pA0, pA1, K_lds, qr, r32, hi);
    finishSM(pB0, pB1, alB, l_reg, pa0, pa1, pa2, pa3); SBAR();
    if (SDEPTH == 1 || j + 3 < NT) SLOAD(SE, (j + 1 + SDEPTH) * KVBLK); SBAR();
    pv_d0(o, vb0 + (int)SHM_V, pa0, pa1, pa2, pa3); partialSM(pA0, pA1, m_reg, mnA, alA);
    __syncthreads(); SWAIT(); SWRITE(1, SO);
    RESC(alA); __syncthreads();
  }
  SBAR(); qkt(pB0, pB1, (bf16*)((char*)K_lds + SHM_K), qr, r32, hi);
  finishSM(pA0, pA1, alA, l_reg, pa0, pa1, pa2, pa3); SBAR();
  pv_d0(o, vb0, pa0, pa1, pa2, pa3); partialSM(pB0, pB1, m_reg, mnB, alB);
  __syncthreads(); RESC(alB);
  finishSM(pB0, pB1, alB, l_reg, pa0, pa1, pa2, pa3); SBAR();
  pv_d0(o, vb0 + (int)SHM_V, pa0, pa1, pa2, pa3);
  if (hi == 0) li_l[r32] = l_reg; asm volatile("s_waitcnt lgkmcnt(0)" ::: "memory");
  float rli[16];
#pragma unroll
  for (int r = 0; r < 16; ++r) rli[r] = __builtin_amdgcn_rcpf(li_l[crow(r, hi)]);
  unsigned short* Ow = Ob + (long)(wid * QBLK) * LDO;
#pragma unroll
  for (int r = 0; r < 16; ++r) { int orow = crow(r, hi);
    for (int d0 = 0; d0 < 4; ++d0) Ow[(long)orow * LDO + d0 * 32 + r32] = (unsigned short)(cvtpk(o[d0][r] * rli[r], 0.f) & 0xffffu); }
#undef SLOAD
#undef SWRITE
#undef SWAIT
#undef RESC
}
}
using pg8::bf16_t; using pg8::f32x4; using pg8::u32x4; using pg8::Unit; using pg8::cvt_pk_bf16;
typedef unsigned u32x2 __attribute__((ext_vector_type(2)));
struct Args { const float* in[20]; float* out; unsigned char* ws; };
enum { I_XP = 0, I_XS, I_CK, I_CV, I_C, I_CCTX, I_WMOD, I_BMOD, I_WIN, I_QG, I_KG, I_WPOOL, I_PSCALE, I_WOUT, I_LN1G, I_LN1B, I_WFF1, I_WFF2, I_LN2G, I_LN2B };

__device__ __forceinline__ float wave_sum(float v) {
#pragma unroll
    for (int o = 32; o >= 1; o >>= 1) v += __shfl_xor(v, o);
    return v;
}
__device__ __forceinline__ float bf_lo(unsigned w) { return __uint_as_float(w << 16); }
__device__ __forceinline__ float bf_hi(unsigned w) { return __uint_as_float(w & 0xffff0000u); }
__device__ __forceinline__ int mod_row_of(int row) { return row < MCTX ? 4 : ((row - MCTX) >> 12); }
__device__ __forceinline__ const float* x_row(const Args& a, int row) { return row < MCTX ? a.in[I_XP] + (size_t)row * DM : a.in[I_XS] + (size_t)(row - MCTX) * DM; }

template <int ACT  , bool CS  > struct EpiB {
    static constexpr bool PERM = true, AFTER_DRAIN = false;
    bf16_t* O; int ldc; const float* cs;
    __device__ __forceinline__ void operator()(const f32x4 (&acc)[2][2][4][2], const Unit& u, int wr, int wc, int fr, int fq) const {
        const int row0 = u.pm * 256 + wr * 64 + fr, col0 = u.pn * 256 + wc * 32 + 8 * fq;
#pragma unroll
        for (int bj = 0; bj < 2; ++bj) {
            f32x4 sv0 = {1.f, 1.f, 1.f, 1.f}, sv1 = sv0;
            if (CS) { sv0 = *(const f32x4*)(cs + col0 + bj * 128); sv1 = *(const f32x4*)(cs + col0 + bj * 128 + 4); }
#pragma unroll
            for (int ai = 0; ai < 2; ++ai)
#pragma unroll
                for (int m = 0; m < 4; ++m) { bf16_t* rowp = O + (size_t)(row0 + ai * 128 + m * 16) * ldc + col0 + bj * 128;
                    f32x4 v0 = acc[ai][bj][m][0], v1 = acc[ai][bj][m][1];
                    if (ACT == 1) {
#pragma unroll
                        for (int j = 0; j < 4; ++j) { const float r0 = fmaxf(v0[j], 0.f), r1 = fmaxf(v1[j], 0.f); v0[j] = r0 * r0; v1[j] = r1 * r1; } }
                    if (CS) { v0 = v0 * sv0; v1 = v1 * sv1; }
                    u32x4 w; w.x = cvt_pk_bf16(v0[0], v0[1]); w.y = cvt_pk_bf16(v0[2], v0[3]); w.z = cvt_pk_bf16(v1[0], v1[1]); w.w = cvt_pk_bf16(v1[2], v1[3]);
                    *(u32x4*)rowp = w; }
            asm volatile("" ::: "memory");
        }
    }
};
template <bool INPLACE> struct EpiRes {
    static constexpr bool PERM = false, AFTER_DRAIN = false;
    const float* xp; const float* xs; float* out; const float* gate;
    __device__ __forceinline__ void operator()(const f32x4 (&acc)[2][2][4][2], const Unit& u, int wr, int wc, int fr, int fq) const {
        const int row0 = u.pm * 256 + wr * 64 + fr, col0 = u.pn * 256 + wc * 32 + 4 * fq;
        const int mrow = u.pm < 16 ? 4 : ((u.pm - 16) >> 4);
        const float* gp = gate + (size_t)mrow * NMOD + col0;
        f32x4 gv[2][2];
#pragma unroll
        for (int bj = 0; bj < 2; ++bj)
#pragma unroll
            for (int n = 0; n < 2; ++n) gv[bj][n] = *(const f32x4*)(gp + bj * 128 + n * 16);
#pragma unroll
        for (int ai = 0; ai < 2; ++ai)
#pragma unroll
            for (int m = 0; m < 4; ++m) { const int row = row0 + ai * 128 + m * 16;
                float* orow = out + (size_t)row * DM + col0;
                const float* brow = INPLACE ? (const float*)orow : ((row < MCTX ? xp + (size_t)row * DM : xs + (size_t)(row - MCTX) * DM) + col0);
#pragma unroll
                for (int bj = 0; bj < 2; ++bj)
#pragma unroll
                    for (int n = 0; n < 2; ++n) { const f32x4 bs = *(const f32x4*)(brow + bj * 128 + n * 16);
                        *(f32x4*)(orow + bj * 128 + n * 16) = bs * ALPHA + gv[bj][n] * acc[ai][bj][m][n]; }
                asm volatile("" ::: "memory"); }
    }
};

__device__ __forceinline__ void transpose_tile(const float* __restrict__ W, int Krows, int Ncols, bf16_t* __restrict__ WT, int kt, int nt, float* tile) {
    int tid_l = threadIdx.x; asm volatile("" : "+v"(tid_l)); const int t = tid_l;
#pragma unroll
    for (int i = 0; i < 2; ++i) { const int r = (t >> 4) + 32 * i, c4 = (t & 15) * 4;
        const f32x4 v = *(const f32x4*)(W + (size_t)(kt * 64 + r) * Ncols + nt * 64 + c4);
        tile[r * 65 + c4 + 0] = v[0]; tile[r * 65 + c4 + 1] = v[1]; tile[r * 65 + c4 + 2] = v[2]; tile[r * 65 + c4 + 3] = v[3]; }
    __syncthreads();
    const int n = t >> 3, k8 = (t & 7) * 8;
    float f0 = tile[(k8 + 0) * 65 + n], f1 = tile[(k8 + 1) * 65 + n], f2 = tile[(k8 + 2) * 65 + n], f3 = tile[(k8 + 3) * 65 + n];
    float f4 = tile[(k8 + 4) * 65 + n], f5 = tile[(k8 + 5) * 65 + n], f6 = tile[(k8 + 6) * 65 + n], f7 = tile[(k8 + 7) * 65 + n];
    u32x4 w; w.x = cvt_pk_bf16(f0, f1); w.y = cvt_pk_bf16(f2, f3); w.z = cvt_pk_bf16(f4, f5); w.w = cvt_pk_bf16(f6, f7);
    *(u32x4*)(WT + (size_t)(nt * 64 + n) * Krows + kt * 64 + k8) = w;
    __syncthreads();
}
__device__ __forceinline__ void mod_job(const Args& a, int job, float* mod, float* lds) {
    float* sil = lds; float* red = lds + 5 * DM;
    const int t = threadIdx.x;
    for (int i = t; i < 5 * DM; i += 512) { const float x = (i < 4 * DM) ? a.in[I_C][i] : a.in[I_CCTX][i - 4 * DM]; sil[i] = x / (1.f + __expf(-x)); }
    __syncthreads();
    const int cg4 = t & 15, ch = t >> 4, col0 = job * 64 + cg4 * 4;
    f32x4 a0 = {0.f, 0.f, 0.f, 0.f}, a1 = a0, a2 = a0, a3 = a0, a4 = a0;
    const float* wp = a.in[I_WMOD] + (size_t)(ch * 64) * NMOD + col0;
#pragma unroll 8
    for (int i = 0; i < 64; ++i) { const f32x4 w = *(const f32x4*)(wp + (size_t)i * NMOD); const int d = ch * 64 + i;
        a0 += w * sil[d]; a1 += w * sil[DM + d]; a2 += w * sil[2 * DM + d]; a3 += w * sil[3 * DM + d]; a4 += w * sil[4 * DM + d]; }
    *(f32x4*)(red + (ch * 5 + 0) * 64 + cg4 * 4) = a0; *(f32x4*)(red + (ch * 5 + 1) * 64 + cg4 * 4) = a1; *(f32x4*)(red + (ch * 5 + 2) * 64 + cg4 * 4) = a2;
    *(f32x4*)(red + (ch * 5 + 3) * 64 + cg4 * 4) = a3; *(f32x4*)(red + (ch * 5 + 4) * 64 + cg4 * 4) = a4;
    __syncthreads();
    if (t < 320) { const int r = t >> 6, col = t & 63; float s = 0.f;
#pragma unroll 8
        for (int c = 0; c < 32; ++c) s += red[(c * 5 + r) * 64 + col];
        mod[(size_t)r * NMOD + job * 64 + col] = s + a.in[I_BMOD][job * 64 + col]; }
    __syncthreads();
}
__device__ void phase_prep(const Args& a, float* lds) {
    unsigned char* ws = a.ws;
    float* mod = (float*)(ws + WS_MOD);
    constexpr int J_MOD = NMOD / 64, J_WIN = 32 * 40, J_WOUT = 32 * 32, J_FF1 = 32 * 128, J_FF2 = 128 * 32, J_POOL = 4 * 16;
    constexpr int NJ = J_MOD + J_WIN + J_WOUT + J_FF1 + J_FF2 + J_POOL;
    for (int job = blockIdx.x; job < NJ; job += gridDim.x) {
        int j = job;
        if (j < J_MOD) { mod_job(a, j, mod, lds); continue; }
        j -= J_MOD;
        if (j < J_WIN) { transpose_tile(a.in[I_WIN], DM, NIN, (bf16_t*)(ws + WS_WIN), j / 40, j % 40, lds); continue; }
        j -= J_WIN;
        if (j < J_WOUT) { transpose_tile(a.in[I_WOUT], DM, DM, (bf16_t*)(ws + WS_WOUT), j / 32, j % 32, lds); continue; }
        j -= J_WOUT;
        if (j < J_FF1) { transpose_tile(a.in[I_WFF1], DM, DFF, (bf16_t*)(ws + WS_WFF1), j / 128, j % 128, lds); continue; }
        j -= J_FF1;
        if (j < J_FF2) { transpose_tile(a.in[I_WFF2], DFF, DM, (bf16_t*)(ws + WS_WFF2), j / 32, j % 32, lds); continue; }
        j -= J_FF2;
        { const int g = j >> 4, tt = j & 15; transpose_tile(a.in[I_WPOOL] + (size_t)g * 65536, 256, 256, (bf16_t*)(ws + WS_WPOOL) + (size_t)g * 65536, tt >> 2, tt & 3, lds); }
    }
    bf16_t* klat = (bf16_t*)(ws + WS_KLAT); bf16_t* vlat = (bf16_t*)(ws + WS_VLAT);
    constexpr int NC8 = 4 * 512 * 256 / 8;
    for (int i = blockIdx.x * 512 + threadIdx.x; i < 2 * NC8; i += gridDim.x * 512) {
        const bool isk = i < NC8; const int e = (isk ? i : i - NC8) * 8;
        const float* src = (isk ? a.in[I_CK] : a.in[I_CV]) + e;
        const f32x4 v0 = *(const f32x4*)src, v1 = *(const f32x4*)(src + 4);
        const int b = e / (512 * 256), rem = e % (512 * 256);
        bf16_t* dst = (isk ? klat : vlat) + (size_t)b * SKV_LAT * 256 + rem;
        u32x4 w; w.x = cvt_pk_bf16(v0[0], v0[1]); w.y = cvt_pk_bf16(v0[2], v0[3]); w.z = cvt_pk_bf16(v1[0], v1[1]); w.w = cvt_pk_bf16(v1[2], v1[3]);
        *(u32x4*)dst = w;
    }
}

__device__ __forceinline__ void row_stats(const f32x4 (&v)[8], float& mu, float& rstd) {
    float s = 0.f;
#pragma unroll
    for (int i = 0; i < 8; ++i) s += (v[i][0] + v[i][1]) + (v[i][2] + v[i][3]);
    s = wave_sum(s); mu = s * (1.f / DM);
    float q = 0.f;
#pragma unroll
    for (int i = 0; i < 8; ++i) { const f32x4 d = v[i] - mu; q += (d[0] * d[0] + d[1] * d[1]) + (d[2] * d[2] + d[3] * d[3]); }
    q = wave_sum(q); rstd = 1.0f / sqrtf(q * (1.f / DM) + LN_EPS);
}
__device__ void phase_ln_in(const Args& a) {
    int tid_l = threadIdx.x; asm volatile("" : "+v"(tid_l));
    const int lane = tid_l & 63, wid = tid_l >> 6;
    const float* mod = (const float*)(a.ws + WS_MOD); bf16_t* U = (bf16_t*)(a.ws + WS_ACT);
    for (int row = blockIdx.x * 8 + wid; row < MTOT; row += gridDim.x * 8) {
        const float* xr = x_row(a, row); f32x4 v[8];
#pragma unroll
        for (int i = 0; i < 8; ++i) v[i] = *(const f32x4*)(xr + i * 256 + lane * 4);
        float mu, rstd; row_stats(v, mu, rstd);
        const float* mp = mod + (size_t)mod_row_of(row) * NMOD;
#pragma unroll
        for (int i = 0; i < 8; ++i) { const int col = i * 256 + lane * 4;
            const f32x4 sh = *(const f32x4*)(mp + col), sc = *(const f32x4*)(mp + DM + col);
            const f32x4 o = (v[i] - mu) * rstd * (sc + 1.0f) + sh;
            u32x2 w; w.x = cvt_pk_bf16(o[0], o[1]); w.y = cvt_pk_bf16(o[2], o[3]);
            *(u32x2*)(U + (size_t)row * DM + col) = w; }
    }
}
__device__ void phase_ln_mid(const Args& a) {
    int tid_l = threadIdx.x; asm volatile("" : "+v"(tid_l));
    const int lane = tid_l & 63, wid = tid_l >> 6;
    const float* mod = (const float*)(a.ws + WS_MOD); bf16_t* U = (bf16_t*)(a.ws + WS_ACT);
    for (int row = blockIdx.x * 8 + wid; row < MTOT; row += gridDim.x * 8) {
        float* yr = a.out + (size_t)row * DM; f32x4 v[8];
#pragma unroll
        for (int i = 0; i < 8; ++i) v[i] = *(const f32x4*)(yr + i * 256 + lane * 4);
        float mu, rstd; row_stats(v, mu, rstd);
#pragma unroll
        for (int i = 0; i < 8; ++i) { const int col = i * 256 + lane * 4;
            const f32x4 g = *(const f32x4*)(a.in[I_LN1G] + col), b = *(const f32x4*)(a.in[I_LN1B] + col);
            v[i] = (v[i] - mu) * rstd * g + b; *(f32x4*)(yr + col) = v[i]; }
        row_stats(v, mu, rstd);
        const float* mp = mod + (size_t)mod_row_of(row) * NMOD + 3 * DM;
#pragma unroll
        for (int i = 0; i < 8; ++i) { const int col = i * 256 + lane * 4;
            const f32x4 sh = *(const f32x4*)(mp + col), sc = *(const f32x4*)(mp + DM + col);
            const f32x4 o = (v[i] - mu) * rstd * (sc + 1.0f) + sh;
            u32x2 w; w.x = cvt_pk_bf16(o[0], o[1]); w.y = cvt_pk_bf16(o[2], o[3]);
            *(u32x2*)(U + (size_t)row * DM + col) = w; }
    }
}
__device__ void phase_ln_out(const Args& a) {
    int tid_l = threadIdx.x; asm volatile("" : "+v"(tid_l));
    const int lane = tid_l & 63, wid = tid_l >> 6;
    for (int row = blockIdx.x * 8 + wid; row < MTOT; row += gridDim.x * 8) {
        float* yr = a.out + (size_t)row * DM; f32x4 v[8];
#pragma unroll
        for (int i = 0; i < 8; ++i) v[i] = *(const f32x4*)(yr + i * 256 + lane * 4);
        float mu, rstd; row_stats(v, mu, rstd);
#pragma unroll
        for (int i = 0; i < 8; ++i) { const int col = i * 256 + lane * 4;
            const f32x4 g = *(const f32x4*)(a.in[I_LN2G] + col), b = *(const f32x4*)(a.in[I_LN2B] + col);
            *(f32x4*)(yr + col) = (v[i] - mu) * rstd * g + b; }
    }
}

__device__ void phase_elem(const Args& a) {
    int tid_l = threadIdx.x; asm volatile("" : "+v"(tid_l));
    const int lane = tid_l & 63, wid = tid_l >> 6;
    unsigned char* ws = a.ws;
    const bf16_t* PROJ = (const bf16_t*)(ws + WS_PROJ);
    bf16_t* Q = (bf16_t*)(ws + WS_Q); bf16_t* KL = (bf16_t*)(ws + WS_KLAT); bf16_t* VL = (bf16_t*)(ws + WS_VLAT);
    bf16_t* KC = (bf16_t*)(ws + WS_KCTX); bf16_t* VC = (bf16_t*)(ws + WS_VCTX); bf16_t* PO = (bf16_t*)(ws + WS_POOLED);
    float* ctxk = a.out + (size_t)MTOT * DM; float* ctxv = ctxk + (size_t)MCTX * 256;
    const float qg0 = a.in[I_QG][2 * lane], qg1 = a.in[I_QG][2 * lane + 1], kg0 = a.in[I_KG][2 * lane], kg1 = a.in[I_KG][2 * lane + 1];
    const int jf = lane & 15; const bool second = (lane >> 4) & 1, colpart = lane >= 32;
    const float if0 = exp2f(-(float)(2 * jf) * (13.287712379549449f / 32.f)), if1 = exp2f(-(float)(2 * jf + 1) * (13.287712379549449f / 32.f));
    for (int tok = blockIdx.x * 8 + wid; tok < MTOT; tok += gridDim.x * 8) {
        const bool lat = tok >= MCTX;
        int b, s, T; if (!lat) { b = tok >> 8; s = tok & 255; T = 256; } else { const int tt = tok - MCTX; b = tt >> 12; s = tt & 4095; T = 4096; }
        const bf16_t* pr = PROJ + (size_t)tok * NIN;
        float c0 = 1.f, s0 = 0.f, c1 = 1.f, s1 = 0.f;
        if (lat) { const float pos = (float)(colpart ? (s & 63) : (s >> 6)); const float a0 = pos * if0, a1 = pos * if1;
            c0 = cosf(a0); s0 = sinf(a0); c1 = cosf(a1); s1 = sinf(a1);
            if (!second) { s0 = -s0; s1 = -s1; } }
#pragma unroll 2
        for (int h = 0; h < 8; ++h) {
            const unsigned w = *(const unsigned*)(pr + h * 128 + 2 * lane);
            float x0 = bf_lo(w), x1 = bf_hi(w);
            const float ss = wave_sum(x0 * x0 + x1 * x1); const float rinv = 1.0f / sqrtf(ss * (1.f / 128.f) + LN_EPS);
            x0 = x0 * rinv * qg0; x1 = x1 * rinv * qg1;
            if (lat) { const float p0 = __shfl_xor(x0, 16), p1 = __shfl_xor(x1, 16); x0 = x0 * c0 + p0 * s0; x1 = x1 * c1 + p1 * s1; }
            *(unsigned*)(Q + (size_t)tok * 1024 + h * 128 + 2 * lane) = cvt_pk_bf16(x0, x1);
        }
#pragma unroll
        for (int h = 0; h < 2; ++h) {
            const unsigned w = *(const unsigned*)(pr + 1024 + h * 128 + 2 * lane);
            float x0 = bf_lo(w), x1 = bf_hi(w);
            const float ss = wave_sum(x0 * x0 + x1 * x1); const float rinv = 1.0f / sqrtf(ss * (1.f / 128.f) + LN_EPS);
            x0 = x0 * rinv * kg0; x1 = x1 * rinv * kg1;
            if (lat) { const float p0 = __shfl_xor(x0, 16), p1 = __shfl_xor(x1, 16); x0 = x0 * c0 + p0 * s0; x1 = x1 * c1 + p1 * s1;
                *(unsigned*)(KL + ((size_t)b * SKV_LAT + 512 + s) * 256 + h * 128 + 2 * lane) = cvt_pk_bf16(x0, x1); }
            else { *(unsigned*)(KC + (size_t)tok * 256 + h * 128 + 2 * lane) = cvt_pk_bf16(x0, x1);
                float2 o; o.x = x0; o.y = x1; *(float2*)(ctxk + (size_t)tok * 256 + h * 128 + 2 * lane) = o; }
        }
        { const u32x2 w = *(const u32x2*)(pr + 1280 + 4 * lane);
            if (lat) *(u32x2*)(VL + ((size_t)b * SKV_LAT + 512 + s) * 256 + 4 * lane) = w;
            else { *(u32x2*)(VC + (size_t)tok * 256 + 4 * lane) = w;
                f32x4 o; o[0] = bf_lo(w.x); o[1] = bf_hi(w.x); o[2] = bf_lo(w.y); o[3] = bf_hi(w.y); *(f32x4*)(ctxv + (size_t)tok * 256 + 4 * lane) = o; } }
        const bf16_t* pbase = PROJ + (size_t)(tok - s) * NIN + 1536 + 4 * lane;
#pragma unroll
        for (int g = 0; g < 4; ++g) {
            const int half = 1 << g; const int lo = max(s - half, 0), hi = min(s + half, T);
            f32x4 acc = {0.f, 0.f, 0.f, 0.f};
            for (int r = lo; r < hi; ++r) { const u32x2 w = *(const u32x2*)(pbase + (size_t)r * NIN + g * 256);
                acc[0] += bf_lo(w.x); acc[1] += bf_hi(w.x); acc[2] += bf_lo(w.y); acc[3] += bf_hi(w.y); }
            const u32x2 sw = *(const u32x2*)(pbase + (size_t)s * NIN + g * 256);
            const float ic = 1.0f / (float)(hi - lo);
            const float o0 = acc[0] * ic - bf_lo(sw.x), o1 = acc[1] * ic - bf_hi(sw.x), o2 = acc[2] * ic - bf_lo(sw.y), o3 = acc[3] * ic - bf_hi(sw.y);
            u32x2 ow; ow.x = cvt_pk_bf16(o0, o1); ow.y = cvt_pk_bf16(o2, o3);
            *(u32x2*)(PO + (size_t)tok * 1024 + g * 256 + 4 * lane) = ow;
        }
    }
}

__global__ void __launch_bounds__(512, 2) mega_fwd(Args a) {
    extern __shared__ __attribute__((aligned(16))) unsigned char shm[];
    cg::grid_group grid = cg::this_grid();
    unsigned char* ws = a.ws;
    PG8_LAS unsigned char* lds3 = (PG8_LAS unsigned char*)shm;
    const int G = gridDim.x, bid = blockIdx.x;
    const float* mod = (const float*)(ws + WS_MOD);
    bf16_t* ACT = (bf16_t*)(ws + WS_ACT);

#ifndef PH_MASK
#define PH_MASK 0xFFFF
#endif
    if (PH_MASK & 1) phase_prep(a, (float*)shm);
    grid.sync();
    if (PH_MASK & 2) phase_ln_in(a);
    grid.sync();
    if (PH_MASK & 4) { pg8::Gemm g{ACT, (const bf16_t*)(ws + WS_WIN), MTOT, NIN, DM, DM, DM, 0}; pg8::StaticOrder S; S.init(MTOT, NIN, G, bid);
      EpiB<0, false> E{(bf16_t*)(ws + WS_PROJ), NIN, nullptr};
      pg8::gemm_phase<EpiB<0, false>, pg8::StaticOrder>(lds3, g, S, E, nullptr); }
    grid.sync();
    if (PH_MASK & 8) phase_elem(a);
    grid.sync();
    if (PH_MASK & 16) {
        const att::bf16* Qb = (const att::bf16*)(ws + WS_Q);
#ifndef NO_ATT
        for (int u = bid; u < 640; u += G) {
            const bool lat = u < 512; const int uu = lat ? u : u - 512;
            const int h = lat ? ((uu >> 4) & 7) : (uu & 7), b = lat ? (uu >> 7) : (uu >> 3);
            const size_t tok0 = lat ? ((size_t)MCTX + (size_t)b * 4096 + (uu & 15) * 256) : (size_t)b * 256;
            const size_t kvoff = (lat ? (size_t)b * SKV_LAT * 256 : tok0 * 256) + (h >> 2) * 128;
            const att::bf16* Kh = (const att::bf16*)(ws + (lat ? WS_KLAT : WS_KCTX)) + kvoff;
            const att::bf16* Vh = (const att::bf16*)(ws + (lat ? WS_VLAT : WS_VCTX)) + kvoff;
            __syncthreads();
            att::attn_dense_body<att::bf16>(Qb + tok0 * 1024 + h * 128, Kh, Vh, ACT + tok0 * DM + h * 128, lat ? SKV_LAT : 256, (char*)shm);
        }
#endif
        __syncthreads();
#ifndef NO_POOLG
        pg8::Gemm g{(const bf16_t*)(ws + WS_POOLED), (const bf16_t*)(ws + WS_WPOOL), MTOT, 1024, 256, 1024, 256, 512}; pg8::StaticOrder S; S.init(MTOT, 1024, G, bid);
        EpiB<0, true> E{ACT + 1024, DM, a.in[I_PSCALE]};
        pg8::gemm_phase<EpiB<0, true>, pg8::StaticOrder>(lds3, g, S, E, nullptr);
#endif
    }
    grid.sync();
    if (PH_MASK & 32) { pg8::Gemm g{ACT, (const bf16_t*)(ws + WS_WOUT), MTOT, DM, DM, DM, DM, 0}; pg8::StaticOrder S; S.init(MTOT, DM, G, bid);
      EpiRes<false> E{a.in[I_XP], a.in[I_XS], a.out, mod + 2 * DM};
      pg8::gemm_phase<EpiRes<false>, pg8::StaticOrder>(lds3, g, S, E, nullptr); }
    grid.sync();
    if (PH_MASK & 64) phase_ln_mid(a);
    grid.sync();
    if (PH_MASK & 128) { pg8::Gemm g{ACT, (const bf16_t*)(ws + WS_WFF1), MTOT, DFF, DM, DM, DM, 0}; pg8::StaticOrder S; S.init(MTOT, DFF, G, bid);
      EpiB<1, false> E{(bf16_t*)(ws + WS_H), DFF, nullptr};
      pg8::gemm_phase<EpiB<1, false>, pg8::StaticOrder>(lds3, g, S, E, nullptr); }
    grid.sync();
    if (PH_MASK & 256) { pg8::Gemm g{(const bf16_t*)(ws + WS_H), (const bf16_t*)(ws + WS_WFF2), MTOT, DM, DFF, DFF, DFF, 0}; pg8::StaticOrder S; S.init(MTOT, DM, G, bid);
      EpiRes<true> E{nullptr, nullptr, a.out, mod + 5 * DM};
      pg8::gemm_phase<EpiRes<true>, pg8::StaticOrder>(lds3, g, S, E, nullptr); }
    grid.sync();
    if (PH_MASK & 512) phase_ln_out(a);
}

extern "C" void kernel_launch(void* const* d_in, const int* in_sizes, int n_in, void* d_out, int out_size, void* d_ws, size_t ws_size, hipStream_t stream) {
    static int grid = 0;
    if (grid == 0) {
        if (n_in != 20 || ws_size < WS_END) { fprintf(stderr, "kernel_launch: need 20 inputs and %zu bytes of workspace (got %d, %zu)\n", (size_t)WS_END, n_in, ws_size); grid = -1; return; }
        int dev = 0, cus = 0, per_cu = 0;
        hipGetDevice(&dev); hipDeviceGetAttribute(&cus, hipDeviceAttributeMultiprocessorCount, dev);
        if (hipFuncSetAttribute((const void*)mega_fwd, hipFuncAttributeMaxDynamicSharedMemorySize, LDS_BYTES) != hipSuccess) { fprintf(stderr, "kernel_launch: hipFuncSetAttribute failed\n"); grid = -1; return; }
        if (hipOccupancyMaxActiveBlocksPerMultiprocessor(&per_cu, (const void*)mega_fwd, 512, LDS_BYTES) != hipSuccess || per_cu < 1) { fprintf(stderr, "kernel_launch: occupancy query says %d\n", per_cu); per_cu = 1; }
        (void)hipGetLastError();
        grid = cus * 1;
    }
    if (grid < 0) return;
    Args a{};
    for (int i = 0; i < 20; ++i) a.in[i] = (const float*)d_in[i];
    a.out = (float*)d_out; a.ws = (unsigned char*)d_ws;
    void* args[] = {&a};
    hipError_t e = hipLaunchCooperativeKernel((const void*)mega_fwd, dim3(grid), dim3(512), args, LDS_BYTES, stream);
    if (e != hipSuccess) fprintf(stderr, "kernel_launch: cooperative launch failed: %s (grid %d)\n", hipGetErrorString(e), grid);
}
```

```cpp
#include <hip/hip_runtime.h>
#include <hip/hip_bf16.h>
#include <hip/hip_cooperative_groups.h>
#include <cstdio>
#include <cstdint>
namespace cg = cooperative_groups;

constexpr int DM = 2048, MCTX = 4096, MLAT = 16384, MTOT = 20480, NIN = 2560, DFF = 8192, SKV_LAT = 4608, NMOD = 12288;
constexpr float LN_EPS = 1e-6f, ALPHA = 1.189207115002721f;
constexpr size_t al256(size_t x) { return (x + 255) / 256 * 256; }
constexpr size_t WS_WIN = 0;
constexpr size_t WS_WOUT = WS_WIN + (size_t)NIN * DM * 2;
constexpr size_t WS_WFF1 = WS_WOUT + (size_t)DM * DM * 2;
constexpr size_t WS_WFF2 = WS_WFF1 + (size_t)DFF * DM * 2;
constexpr size_t WS_WPOOL = WS_WFF2 + (size_t)DFF * DM * 2;
constexpr size_t WS_MOD = WS_WPOOL + (size_t)1024 * 256 * 2;
constexpr size_t WS_ROPE = WS_MOD + al256((size_t)5 * NMOD * 4);
constexpr size_t WS_BAR = WS_ROPE + 16384;
constexpr size_t WS_ACT = WS_BAR + 16384;
constexpr size_t WS_BIG = WS_ACT + (size_t)MTOT * DM * 2;
constexpr size_t WS_PROJ = WS_BIG;
constexpr size_t WS_Q = WS_PROJ + (size_t)MTOT * NIN * 2;
constexpr size_t WS_KLAT = WS_Q + (size_t)MTOT * 1024 * 2;
constexpr size_t WS_VLAT = WS_KLAT + (size_t)4 * SKV_LAT * 256 * 2;
constexpr size_t WS_KCTX = WS_VLAT + (size_t)4 * SKV_LAT * 256 * 2;
constexpr size_t WS_VCTX = WS_KCTX + (size_t)MCTX * 256 * 2;
constexpr size_t WS_POOLED = WS_VCTX + (size_t)MCTX * 256 * 2;
constexpr size_t WS_BIG_END1 = WS_POOLED + (size_t)MTOT * 1024 * 2;
constexpr size_t WS_H = WS_BIG;
constexpr size_t WS_STATS = WS_H + (size_t)MTOT * DFF * 2;
constexpr size_t WS_PART = WS_STATS + al256((size_t)MTOT * 2 * 4);
constexpr size_t WS_END = WS_PART + (size_t)4096 * DM * 2;
static_assert(WS_BIG_END1 <= WS_END, "aliasing");
constexpr int LDS_BYTES = 131072 + 16;

namespace pg8 {
#define PG8_LAS __attribute__((address_space(3)))
typedef unsigned short bf16_t;
typedef short bf16x8 __attribute__((ext_vector_type(8)));
typedef float f32x4 __attribute__((ext_vector_type(4)));
typedef unsigned u32x4 __attribute__((ext_vector_type(4)));
constexpr int BM = 256, BK = 64, HALF = 128, HTB = HALF * BK * 2  , STAGE_BYTES = 8 * HTB, NXCD = 8, WGM = 8;

__host__ __device__ __forceinline__ int lds_byte(int r, int c) { const int st = (r >> 4) * 2 + (c >> 5), rr = r & 15, cc = c & 31, ob = rr * 64 + cc * 2; return st * 1024 + (ob ^ (((ob >> 9) & 1) << 5)); }
__host__ __device__ __forceinline__ void stage_rc(int b, int& R, int& C) { const int st = b / 1024, sb = b % 1024, swz = sb ^ (((sb >> 9) & 1) << 5); R = (st >> 1) * 16 + swz / 64; C = (st & 1) * 32 + (swz % 64) / 2; }
__host__ __device__ __forceinline__ int perm32(int rho) { const int n = rho >> 4, i = rho & 15; return 8 * (i >> 2) + 4 * n + (i & 3); }

struct Unit { int pm, pn, kt0, nkt, ks; };
struct Gemm { const bf16_t* A; const bf16_t* Bt; int M, N, K, lda, ldb, a_pn_off; };

struct StaticOrder {
    int nM, nN, nwg, G, c;
    __host__ __device__ void init(int M, int N, int G_, int c_) { nM = M / BM; nN = N / BM; nwg = nM * nN; G = G_; c = c_; }
    __host__ __device__ bool next(int i, Unit& u) const {
        const long L = (long)i * G + c; if (L >= nwg) return false;
        int wgid = (int)L; { const int q = nwg / NXCD, r = nwg % NXCD, xcd = wgid % NXCD, off = wgid / NXCD; wgid = (xcd < r ? xcd * (q + 1) : r * (q + 1) + (xcd - r) * q) + off; }
        const int nig = WGM * nN, gid = wgid / nig, fm = gid * WGM, gsz = (nM - fm) < WGM ? (nM - fm) : WGM;
        u.pm = fm + ((wgid % nig) % gsz); u.pn = (wgid % nig) / gsz; return true;
    }
    __device__ __forceinline__ void a_ready(const Unit&) const {}
    __device__ __forceinline__ void done(const Unit&) const {}
};
__device__ __forceinline__ unsigned cvt_pk_bf16(float lo, float hi) { unsigned r; asm volatile("v_cvt_pk_bf16_f32 %0, %1, %2" : "=v"(r) : "v"(lo), "v"(hi)); return r; }
template <class Epi, class Sched, bool STAMP = false>
__device__ __forceinline__ void gemm_phase(PG8_LAS unsigned char* lds, const Gemm g, const Sched& S, const Epi& E, unsigned long long* stamps) {
    int tid_l = threadIdx.x; asm volatile("" : "+v"(tid_l));
    const int tid = tid_l, wid = __builtin_amdgcn_readfirstlane(tid >> 6), lane = tid & 63, wr = wid >> 2, wc = wid & 3, fr = lane & 15, fq = lane >> 4;
    const int K = g.K, nt = K / BK;
    int ts_lo = 0, ts_hi = 0, nts = 0; const unsigned long long rt_entry = STAMP ? (unsigned long long)wall_clock64() : 0ull;
#define PG8_STAMP() do { if (STAMP && wid == 0 && nts < 64) { const unsigned long long _c = (unsigned long long)clock64(); \
        ts_lo = (lane == nts) ? (int)(unsigned)_c : ts_lo; ts_hi = (lane == nts) ? (int)(unsigned)(_c >> 32) : ts_hi; ++nts; } } while (0)
    PG8_STAMP();
    unsigned voffA[2], voffB[2];
#pragma unroll
    for (int i = 0; i < 2; ++i) { int R, C; stage_rc(tid * 16 + i * 8192, R, C); const int Rb = Epi::PERM ? ((R & ~31) + perm32(R & 31)) : R;
        voffA[i] = (unsigned)(R * g.lda + C) * 2u; voffB[i] = (unsigned)(Rb * g.ldb + C) * 2u; }
    const size_t kstep = (size_t)(BK * 2);
    const size_t hstepA = (size_t)HALF * g.lda * 2, hstepB = (size_t)HALF * g.ldb * 2;
    const size_t tstepA = 2 * hstepA, tstepB = 2 * hstepB;
    const unsigned ldsw = (unsigned)wid * 1024u;
    const int aoff = lds_byte(wr * 64 + fr, fq * 8), boff = lds_byte(wc * 32 + fr, fq * 8);
#define PG8_SA(b, h) (((b) * 2 + (h)) * HTB)
#define PG8_SB(b, h) ((4 + (b) * 2 + (h)) * HTB)
#define PG8_STAGE(bufoff, gbase, voff) do { _Pragma("unroll") for (int _i = 0; _i < 2; ++_i) \
        __builtin_amdgcn_global_load_lds((const unsigned*)((const char*)(gbase) + (voff)[_i]), (PG8_LAS unsigned*)(lds + (bufoff) + ldsw + _i * 8192), 16, 0, 0); } while (0)
#define PG8_LDA(dst, b, h) do { _Pragma("unroll") for (int m = 0; m < 4; ++m) _Pragma("unroll") for (int k = 0; k < 2; ++k) dst[m][k] = *(const PG8_LAS bf16x8*)(lds + PG8_SA(b, h) + aoff + m * 2048 + k * 1024); } while (0)
#define PG8_LDB(dst, b, h) do { _Pragma("unroll") for (int n = 0; n < 2; ++n) _Pragma("unroll") for (int k = 0; k < 2; ++k) dst[n][k] = *(const PG8_LAS bf16x8*)(lds + PG8_SB(b, h) + boff + n * 2048 + k * 1024); } while (0)
#define PG8_MMA(ai, bj, At, Bt) do { __builtin_amdgcn_s_setprio(1); _Pragma("unroll") for (int m = 0; m < 4; ++m) _Pragma("unroll") for (int n = 0; n < 2; ++n) _Pragma("unroll") for (int k = 0; k < 2; ++k) \
        acc[ai][bj][m][n] = __builtin_amdgcn_mfma_f32_16x16x32_bf16(Bt[n][k], At[m][k], acc[ai][bj][m][n], 0, 0, 0); __builtin_amdgcn_s_setprio(0); } while (0)
#define PG8_WAIT_V(n) asm volatile("s_waitcnt vmcnt(" #n ")" ::: "memory")
#define PG8_WAIT_L(n) asm volatile("s_waitcnt lgkmcnt(" #n ")" ::: "memory")
#define PG8_BAR __builtin_amdgcn_s_barrier()
#define PG8_SCHED __builtin_amdgcn_sched_barrier(0)
    Unit cur, nxt; int ui = 0; cur.kt0 = 0; cur.nkt = nt; cur.ks = 0;
    if (!S.next(0, cur)) return;
    f32x4 acc[2][2][4][2];
#pragma unroll
    for (int a = 0; a < 2; ++a)
#pragma unroll
        for (int b = 0; b < 2; ++b)
#pragma unroll
            for (int m = 0; m < 4; ++m)
#pragma unroll
                for (int n = 0; n < 2; ++n) acc[a][b][m][n] = (f32x4){0.f, 0.f, 0.f, 0.f};
    bf16x8 At[4][2], B0[2][2], B1[2][2];
    const char* cA = (const char*)g.A + (size_t)cur.pm * tstepA + (size_t)cur.pn * g.a_pn_off + (size_t)cur.kt0 * kstep; const char* cB = (const char*)g.Bt + (size_t)cur.pn * tstepB + (size_t)cur.kt0 * kstep;
    S.a_ready(cur);
    PG8_STAGE(PG8_SB(0, 0), cB, voffB); PG8_STAGE(PG8_SA(0, 0), cA, voffA); PG8_STAGE(PG8_SB(0, 1), cB + hstepB, voffB); PG8_STAGE(PG8_SA(0, 1), cA + hstepA, voffA);
    if (wr == 1) PG8_BAR;
    PG8_WAIT_V(4); PG8_BAR;
    PG8_STAGE(PG8_SB(1, 0), cB + kstep, voffB); PG8_STAGE(PG8_SA(1, 0), cA + kstep, voffA); PG8_STAGE(PG8_SB(1, 1), cB + hstepB + kstep, voffB);
    PG8_WAIT_V(6); PG8_BAR;
    PG8_STAMP();
    for (;;) {
        nxt.kt0 = 0; nxt.nkt = nt; nxt.ks = 0;
        const bool has_next = S.next(ui + 1, nxt);
        const char* nA = has_next ? (const char*)g.A + (size_t)nxt.pm * tstepA + (size_t)nxt.pn * g.a_pn_off + (size_t)nxt.kt0 * kstep : cA; const char* nB = has_next ? (const char*)g.Bt + (size_t)nxt.pn * tstepB + (size_t)nxt.kt0 * kstep : cB;
        const int cnt = cur.nkt;
        for (int t = 0; t < cnt; t += 2) {
            const bool last = (t == cnt - 2);
            const char* a1 = cA + (size_t)(t + 1) * kstep;
            const char* a2 = last ? nA : cA + (size_t)(t + 2) * kstep; const char* b2 = last ? nB : cB + (size_t)(t + 2) * kstep;
            const char* a3 = a2 + kstep; const char* b3 = b2 + kstep;
            if (last && has_next) S.a_ready(nxt);
            PG8_LDB(B0, 0, 0); PG8_SCHED; PG8_LDA(At, 0, 0); PG8_STAGE(PG8_SA(1, 1), a1 + hstepA, voffA);
            PG8_WAIT_L(8); PG8_BAR; PG8_WAIT_L(0); PG8_MMA(0, 0, At, B0); PG8_BAR; PG8_SCHED;
            PG8_LDB(B1, 0, 1); PG8_STAGE(PG8_SB(0, 0), b2, voffB);
            PG8_BAR; PG8_WAIT_L(0); PG8_MMA(0, 1, At, B1); PG8_BAR;
            PG8_LDA(At, 0, 1); PG8_STAGE(PG8_SA(0, 0), a2, voffA);
            PG8_BAR; PG8_WAIT_L(0); PG8_MMA(1, 0, At, B0); PG8_BAR; PG8_SCHED;
            PG8_STAGE(PG8_SB(0, 1), b2 + hstepB, voffB);
            PG8_WAIT_V(6); PG8_BAR; PG8_MMA(1, 1, At, B1); PG8_BAR;
            PG8_LDB(B0, 1, 0); PG8_SCHED; PG8_LDA(At, 1, 0); PG8_STAGE(PG8_SA(0, 1), a2 + hstepA, voffA);
            PG8_WAIT_L(8); PG8_BAR; PG8_WAIT_L(0); PG8_MMA(0, 0, At, B0); PG8_BAR; PG8_SCHED;
            PG8_LDB(B1, 1, 1); PG8_STAGE(PG8_SB(1, 0), b3, voffB);
            PG8_BAR; PG8_WAIT_L(0); PG8_MMA(0, 1, At, B1); PG8_BAR;
            PG8_LDA(At, 1, 1); PG8_STAGE(PG8_SA(1, 0), a3, voffA);
            PG8_BAR; PG8_WAIT_L(0); PG8_MMA(1, 0, At, B0); PG8_BAR; PG8_SCHED;
            PG8_STAGE(PG8_SB(1, 1), b3 + hstepB, voffB);
            PG8_WAIT_V(6); PG8_BAR; PG8_MMA(1, 1, At, B1); PG8_BAR;
        }
        PG8_STAMP();
        if constexpr (!Epi::AFTER_DRAIN) { E(acc, cur, wr, wc, fr, fq); S.done(cur); }
        PG8_STAMP();
        if (!has_next) break;
#pragma unroll
        for (int a = 0; a < 2; ++a)
#pragma unroll
            for (int b = 0; b < 2; ++b)
#pragma unroll
                for (int m = 0; m < 4; ++m)
#pragma unroll
                    for (int n = 0; n < 2; ++n) acc[a][b][m][n] = (f32x4){0.f, 0.f, 0.f, 0.f};
        cur = nxt; cA = nA; cB = nB; ++ui;
    }
    PG8_WAIT_V(0);
    if (wr == 0) PG8_BAR;
    PG8_BAR;
    if constexpr (Epi::AFTER_DRAIN) { E.fused(acc, cur, wr, wc, fr, fq, lds, wid, lane); S.done(cur); }
    PG8_STAMP();
    if (STAMP && wid == 0) { stamps[lane] = lane < nts ? (((unsigned long long)(unsigned)ts_hi << 32) | (unsigned)ts_lo) : 0ull;
        if (lane == 62) stamps[62] = rt_entry; if (lane == 63) stamps[63] = (unsigned long long)wall_clock64(); }
#undef PG8_STAMP
#undef PG8_SA
#undef PG8_SB
#undef PG8_STAGE
#undef PG8_LDA
#undef PG8_LDB
#undef PG8_MMA
#undef PG8_WAIT_V
#undef PG8_WAIT_L
#undef PG8_BAR
#undef PG8_SCHED
}
}
namespace att {
using bf16 = __hip_bfloat16;
constexpr int   D = 128, NW = 8, QBLK = 32, KVBLK = 64;
constexpr float SCALE = 0.088388347648318440f;
constexpr float THR = 8.f;
#ifndef ATT_SDEPTH
#define ATT_SDEPTH 2
#endif
constexpr int SDEPTH = ATT_SDEPTH;
constexpr int LDQ = 2560, LDK = 256, LDO = 2048;
constexpr size_t SHM_V = KVBLK * D * 2, SHM_K = KVBLK * D * 2, SHM_ATTN = 2 * SHM_V + 2 * SHM_K + NW * 64 * 4;
using bf16x8 = __attribute__((ext_vector_type(8))) short;
using s16x4  = __attribute__((ext_vector_type(4))) short;
using f32x16 = __attribute__((ext_vector_type(16))) float;
using f32x8  = __attribute__((ext_vector_type(8))) float;
using u32x4  = __attribute__((ext_vector_type(4))) unsigned;
#define KSWZ(row, colB) ((row) * 256 + ((colB) ^ (((row) & 7) << 4)))
#define SBAR() __builtin_amdgcn_sched_barrier(0)
__device__ __forceinline__ int crow(int r, int hi) { return (r & 3) + 8 * (r >> 2) + 4 * hi; }
__device__ __forceinline__ unsigned cvtpk(float lo, float hi) {
  unsigned r; asm volatile("v_cvt_pk_bf16_f32 %0, %1, %2" : "=v"(r) : "v"(lo), "v"(hi)); return r;
}
template <typename TIn> struct Stage;
template <> struct Stage<bf16>  { using T = bf16x8;
  __device__ static __forceinline__ T ld8(const bf16* p) { return *reinterpret_cast<const bf16x8*>(p); }
  __device__ static __forceinline__ bf16x8 tobf(T x) { return x; } };
template <> struct Stage<float> { using T = f32x8;
  __device__ static __forceinline__ T ld8(const float* p) { return *reinterpret_cast<const f32x8*>(p); }
  __device__ static __forceinline__ bf16x8 tobf(T x) {
    u32x4 w = {cvtpk(x[0], x[1]), cvtpk(x[2], x[3]), cvtpk(x[4], x[5]), cvtpk(x[6], x[7])}; return *reinterpret_cast<bf16x8*>(&w); } };

__device__ __forceinline__ void partialSM(f32x16& p0, f32x16& p1, float& m_reg, float& mn, float& alpha) {
  constexpr float C = SCALE * 1.4426950408889634f;
  float pmax = p0[0]; for (int r = 1; r < 16; ++r) pmax = fmaxf(pmax, p0[r]); for (int r = 0; r < 16; ++r) pmax = fmaxf(pmax, p1[r]);
  { auto rr = __builtin_amdgcn_permlane32_swap(__float_as_uint(pmax), __float_as_uint(pmax), false, false);
    pmax = fmaxf(__uint_as_float(rr[0]), __uint_as_float(rr[1])); }
  if (__builtin_expect(__all(pmax - m_reg <= THR / SCALE), 1)) { mn = m_reg; alpha = 1.f; }
  else { mn = fmaxf(m_reg, pmax); alpha = __builtin_amdgcn_exp2f((m_reg - mn) * C); m_reg = mn; }
  float mnC = -mn * C;
  for (int r = 0; r < 16; ++r) p0[r] = fmaf(p0[r], C, mnC); for (int r = 0; r < 16; ++r) p1[r] = fmaf(p1[r], C, mnC);
  for (int r = 0; r < 16; ++r) p0[r] = __builtin_amdgcn_exp2f(p0[r]);
}
__device__ __forceinline__ void finishSM(f32x16& p0, f32x16& p1, float alpha, float& l_reg, bf16x8& pa0, bf16x8& pa1, bf16x8& pa2, bf16x8& pa3) {
  for (int r = 0; r < 16; ++r) p1[r] = __builtin_amdgcn_exp2f(p1[r]);
  float ps = 0; for (int r = 0; r < 16; ++r) ps += p0[r]; for (int r = 0; r < 16; ++r) ps += p1[r];
  { auto rr = __builtin_amdgcn_permlane32_swap(__float_as_uint(ps), __float_as_uint(ps), false, false);
    ps = __uint_as_float(rr[0]) + __uint_as_float(rr[1]); }
  l_reg = l_reg * alpha + ps;
#define PK4(P, BASE, OUT) do { unsigned a0 = cvtpk(P[BASE + 0], P[BASE + 1]), a1 = cvtpk(P[BASE + 2], P[BASE + 3]);   \
    unsigned b0 = cvtpk(P[BASE + 4], P[BASE + 5]), b1 = cvtpk(P[BASE + 6], P[BASE + 7]);                              \
    auto r0 = __builtin_amdgcn_permlane32_swap(a0, b0, false, false); auto r1 = __builtin_amdgcn_permlane32_swap(a1, b1, false, false); \
    u32x4 w = {r0[0], r1[0], r0[1], r1[1]}; OUT = *reinterpret_cast<bf16x8*>(&w); } while (0)
  PK4(p0, 0, pa0); PK4(p0, 8, pa1); PK4(p1, 0, pa2); PK4(p1, 8, pa3);
#undef PK4
}
__device__ __forceinline__ void qkt(f32x16& p0, f32x16& p1, const bf16* Ks, const bf16x8* qr, int r32, int hi) {
  p0 = f32x16{}; p1 = f32x16{};
  for (int d0 = 0; d0 < 8; ++d0) { int cb = (d0 * 16 + hi * 8) * 2;
    bf16x8 b0 = *reinterpret_cast<const bf16x8*>((const char*)Ks + KSWZ(r32, cb));
    bf16x8 b1 = *reinterpret_cast<const bf16x8*>((const char*)Ks + KSWZ(32 + r32, cb));
    p0 = __builtin_amdgcn_mfma_f32_32x32x16_bf16(b0, qr[d0], p0, 0, 0, 0);
    p1 = __builtin_amdgcn_mfma_f32_32x32x16_bf16(b1, qr[d0], p1, 0, 0, 0); }
}
__device__ __forceinline__ int v_st(int k, int c) { const int kk = (k & ~0xC) | ((k & 4) << 1) | ((k & 8) >> 1); return ((kk >> 3) * 4 + (c >> 5)) * 512 + ((kk & 7) * 32 + (c & 31)) * 2; }
__device__ __forceinline__ int v_rd_base(int lane) { return ((lane & 3) << 3) | (((lane >> 2) & 3) << 6) | (((lane >> 4) & 1) << 5) | (((lane >> 5) & 1) << 8); }
constexpr int v_rd_off(int d0, int ks, int half) { return d0 * 512 + ks * 4096 + half * 2048; }
template <int OFF> __device__ __forceinline__ s16x4 tr_read(int vb) {
  s16x4 r; asm volatile("ds_read_b64_tr_b16 %0, %1 offset:%2" : "=&v"(r) : "v"(vb), "i"(OFF) : "memory"); return r;
}
template <int D0> __device__ __forceinline__ void pv_one(f32x16& od, int vb, bf16x8 pa0, bf16x8 pa1, bf16x8 pa2, bf16x8 pa3) {
  const s16x4 l0 = tr_read<v_rd_off(D0, 0, 0)>(vb), h0 = tr_read<v_rd_off(D0, 0, 1)>(vb), l1 = tr_read<v_rd_off(D0, 1, 0)>(vb), h1 = tr_read<v_rd_off(D0, 1, 1)>(vb);
  const s16x4 l2 = tr_read<v_rd_off(D0, 2, 0)>(vb), h2 = tr_read<v_rd_off(D0, 2, 1)>(vb), l3 = tr_read<v_rd_off(D0, 3, 0)>(vb), h3 = tr_read<v_rd_off(D0, 3, 1)>(vb);
  asm volatile("s_waitcnt lgkmcnt(0)" ::: "memory"); SBAR();
#define PK(L, H) (bf16x8){L[0], L[1], L[2], L[3], H[0], H[1], H[2], H[3]}
  od = __builtin_amdgcn_mfma_f32_32x32x16_bf16(pa0, PK(l0, h0), od, 0, 0, 0);
  od = __builtin_amdgcn_mfma_f32_32x32x16_bf16(pa1, PK(l1, h1), od, 0, 0, 0);
  od = __builtin_amdgcn_mfma_f32_32x32x16_bf16(pa2, PK(l2, h2), od, 0, 0, 0);
  od = __builtin_amdgcn_mfma_f32_32x32x16_bf16(pa3, PK(l3, h3), od, 0, 0, 0);
#undef PK
}
__device__ __forceinline__ void pv_d0(f32x16* o, int vb, bf16x8 pa0, bf16x8 pa1, bf16x8 pa2, bf16x8 pa3) {
  pv_one<0>(o[0], vb, pa0, pa1, pa2, pa3); pv_one<1>(o[1], vb, pa0, pa1, pa2, pa3); pv_one<2>(o[2], vb, pa0, pa1, pa2, pa3); pv_one<3>(o[3], vb, pa0, pa1, pa2, pa3);
}

template <typename TQ>
__device__ __forceinline__ void attn_dense_body(const TQ* __restrict__ Qb, const bf16* __restrict__ Kh, const bf16* __restrict__ Vh,
                                                unsigned short* __restrict__ Ob, int seq, char* lds,
                                                const float* __restrict__ qgain, const float* __restrict__ ropeC, const float* __restrict__ ropeS, int s0, bool lat) {
  using St = Stage<bf16>; using SQ = Stage<TQ>;
  int tid_l = threadIdx.x; asm volatile("" : "+v"(tid_l));
  const int tid = tid_l, wid = tid >> 6, lane = tid & 63, r32 = lane & 31, hi = lane >> 5;
  bf16* V_lds = (bf16*)lds; bf16* K_lds = (bf16*)(lds + 2 * SHM_V);
  float* ws = (float*)(lds + 2 * SHM_V + 2 * SHM_K) + wid * 64; float* li_l = ws; float* al_l = ws + 32;
  float m_reg = -1e30f, l_reg = 0; f32x16 o[4] = {}; bf16x8 qr[8];
  const TQ* Qw = Qb + (long)(wid * QBLK + r32) * LDQ + hi * 8;
#pragma unroll
  for (int d0 = 0; d0 < 8; ++d0) qr[d0] = SQ::tobf(SQ::ld8(Qw + d0 * 16));
  {
    float xq[8][8];
#pragma unroll
    for (int d0 = 0; d0 < 8; ++d0) { const u32x4 w = *reinterpret_cast<const u32x4*>(&qr[d0]);
      xq[d0][0] = __uint_as_float(w.x << 16); xq[d0][1] = __uint_as_float(w.x & 0xffff0000u); xq[d0][2] = __uint_as_float(w.y << 16); xq[d0][3] = __uint_as_float(w.y & 0xffff0000u);
      xq[d0][4] = __uint_as_float(w.z << 16); xq[d0][5] = __uint_as_float(w.z & 0xffff0000u); xq[d0][6] = __uint_as_float(w.w << 16); xq[d0][7] = __uint_as_float(w.w & 0xffff0000u); }
    float ss = 0.f;
#pragma unroll
    for (int d0 = 0; d0 < 8; ++d0)
#pragma unroll
      for (int e = 0; e < 8; ++e) ss += xq[d0][e] * xq[d0][e];
    { auto rr = __builtin_amdgcn_permlane32_swap(__float_as_uint(ss), __float_as_uint(ss), false, false); ss = __uint_as_float(rr[0]) + __uint_as_float(rr[1]); }
    const float rinv = 1.0f / sqrtf(ss * (1.f / 128.f) + 1e-6f);
#pragma unroll
    for (int d0 = 0; d0 < 8; ++d0) { const float* gp = qgain + d0 * 16 + hi * 8;
      const float4 g0 = *reinterpret_cast<const float4*>(gp), g1 = *reinterpret_cast<const float4*>(gp + 4);
      xq[d0][0] *= rinv * g0.x; xq[d0][1] *= rinv * g0.y; xq[d0][2] *= rinv * g0.z; xq[d0][3] *= rinv * g0.w;
      xq[d0][4] *= rinv * g1.x; xq[d0][5] *= rinv * g1.y; xq[d0][6] *= rinv * g1.z; xq[d0][7] *= rinv * g1.w; }
    if (lat) {
      const int spos = s0 + wid * QBLK + r32;
#pragma unroll
      for (int part = 0; part < 2; ++part) { const int pos = part ? (spos & 63) : (spos >> 6);
#pragma unroll
        for (int q2 = 0; q2 < 2; ++q2) { const int a = part * 4 + q2, b = a + 2; const int fi0 = q2 * 16 + hi * 8;
          const float* cp = ropeC + pos * 32 + fi0; const float* sp = ropeS + pos * 32 + fi0;
          const float4 c0 = *reinterpret_cast<const float4*>(cp), c1 = *reinterpret_cast<const float4*>(cp + 4), n0 = *reinterpret_cast<const float4*>(sp), n1 = *reinterpret_cast<const float4*>(sp + 4);
          const float cc[8] = {c0.x, c0.y, c0.z, c0.w, c1.x, c1.y, c1.z, c1.w}, sn[8] = {n0.x, n0.y, n0.z, n0.w, n1.x, n1.y, n1.z, n1.w};
#pragma unroll
          for (int e = 0; e < 8; ++e) { const float x1 = xq[a][e], x2 = xq[b][e]; xq[a][e] = x1 * cc[e] - x2 * sn[e]; xq[b][e] = x2 * cc[e] + x1 * sn[e]; } } }
    }
#pragma unroll
    for (int d0 = 0; d0 < 8; ++d0) { u32x4 w = {cvtpk(xq[d0][0], xq[d0][1]), cvtpk(xq[d0][2], xq[d0][3]), cvtpk(xq[d0][4], xq[d0][5]), cvtpk(xq[d0][6], xq[d0][7])}; qr[d0] = *reinterpret_cast<bf16x8*>(&w); }
  }
  const int sr = tid >> 4, sc = (tid & 15) * 8, vst0 = v_st(sr, sc), vst1 = v_st(32 + sr, sc);
  const int vb0 = (int)(uintptr_t)V_lds + v_rd_base(lane);
  struct { typename St::T vs0, vs1, ks0, ks1; } sr_[SDEPTH];
#define SLOAD(i, k0) do { sr_[i].vs0 = St::ld8(&Vh[(long)((k0) + sr) * LDK + sc]); sr_[i].vs1 = St::ld8(&Vh[(long)((k0) + 32 + sr) * LDK + sc]); \
    sr_[i].ks0 = St::ld8(&Kh[(long)((k0) + sr) * LDK + sc]); sr_[i].ks1 = St::ld8(&Kh[(long)((k0) + 32 + sr) * LDK + sc]); } while (0)
#define SWRITE(b, i) do { *(bf16x8*)((char*)V_lds + (b) * SHM_V + vst0) = St::tobf(sr_[i].vs0);          \
    *(bf16x8*)((char*)V_lds + (b) * SHM_V + vst1) = St::tobf(sr_[i].vs1); int kc = sc * 2;               \
    *(bf16x8*)((char*)K_lds + (b) * SHM_K + KSWZ(sr, kc)) = St::tobf(sr_[i].ks0);                       \
    *(bf16x8*)((char*)K_lds + (b) * SHM_K + KSWZ(32 + sr, kc)) = St::tobf(sr_[i].ks1); } while (0)
#define SWAIT() do { if constexpr (SDEPTH == 2) asm volatile("s_waitcnt vmcnt(4)" ::: "memory"); else asm volatile("s_waitcnt vmcnt(0)" ::: "memory"); } while (0)
#define RESC(a) do { if (__any((a) < 1.f)) { if (hi == 0) al_l[r32] = (a); asm volatile("s_waitcnt lgkmcnt(0)" ::: "memory"); \
    for (int d = 0; d < 4; ++d) for (int r = 0; r < 16; ++r) o[d][r] *= al_l[crow(r, hi)]; } } while (0)
  f32x16 pA0, pA1, pB0, pB1; float mnA, mnB, alA, alB; bf16x8 pa0, pa1, pa2, pa3; const int NT = seq / KVBLK;
  constexpr int SE = 0, SO = SDEPTH - 1;
  SLOAD(SE, 0); asm volatile("s_waitcnt vmcnt(0)" ::: "memory"); SWRITE(0, SE); __syncthreads();
  qkt(pA0, pA1, K_lds, qr, r32, hi); partialSM(pA0, pA1, m_reg, mnA, alA);
  SLOAD(SO, KVBLK); if constexpr (SDEPTH == 2) { if (2 < NT) SLOAD(SE, 2 * KVBLK); }
  SWAIT(); SWRITE(1, SO); __syncthreads();
  for (int j = 1; j + 1 < NT; j += 2) {
    SBAR(); qkt(pB0, pB1, (bf16*)((char*)K_lds + SHM_K), qr, r32, hi);
    finishSM(pA0, pA1, alA, l_reg, pa0, pa1, pa2, pa3); SBAR();
    SLOAD(SO, (j + SDEPTH) * KVBLK); SBAR();
    pv_d0(o, vb0, pa0, pa1, pa2, pa3); partialSM(pB0, pB1, m_reg, mnB, alB);
    __syncthreads(); SWAIT(); SWRITE(0, SE);
    RESC(alB); __syncthreads();
    SBAR(); qkt(pA0, pA1, K_lds, qr, r32, hi);
    finishSM(pB0, pB1, alB, l_reg, pa0, pa1, pa2, pa3); SBAR();
    if (SDEPTH == 1 || j + 3 < NT) SLOAD(SE, (j + 1 + SDEPTH) * KVBLK); SBAR();
    pv_d0(o, vb0 + (int)SHM_V, pa0, pa1, pa2, pa3); partialSM(pA0, pA1, m_reg, mnA, alA);
    __syncthreads(); SWAIT(); SWRITE(1, SO);
    RESC(alA); __syncthreads();
  }
  SBAR(); qkt(pB0, pB1, (bf16*)((char*)K_lds + SHM_K), qr, r32, hi);
  finishSM(pA0, pA1, alA, l_reg, pa0, pa1, pa2, pa3); SBAR();
  pv_d0(o, vb0, pa0, pa1, pa2, pa3); partialSM(pB0, pB1, m_reg, mnB, alB);
  __syncthreads(); RESC(alB);
  finishSM(pB0, pB1, alB, l_reg, pa0, pa1, pa2, pa3); SBAR();
  pv_d0(o, vb0 + (int)SHM_V, pa0, pa1, pa2, pa3);
  if (hi == 0) li_l[r32] = l_reg; asm volatile("s_waitcnt lgkmcnt(0)" ::: "memory");
  float rli[16];
#pragma unroll
  for (int r = 0; r < 16; ++r) rli[r] = __builtin_amdgcn_rcpf(li_l[crow(r, hi)]);
  unsigned short* Ow = Ob + (long)(wid * QBLK) * LDO;
#pragma unroll
  for (int r = 0; r < 16; ++r) { int orow = crow(r, hi);
    for (int d0 = 0; d0 < 4; ++d0) Ow[(long)orow * LDO + d0 * 32 + r32] = (unsigned short)(cvtpk(o[d0][r] * rli[r], 0.f) & 0xffffu); }
#undef SLOAD
#undef SWRITE
#undef SWAIT
#undef RESC
}
}
#define XB_TMO      128
#define XB_XCNT(j)  (256  + 64 * (j))
#define XB_XSUB(j)  (1280 + 64 * (j))
#define XB_XGEN(j)  (2304 + 64 * (j))
#define XB_TOP      3328
#define XB_TOPGEN   3392
#define XCD_BAR_WORDS 3456
#define XB_SPIN_CAP (1u << 18)
#define LAS __attribute__((address_space(3)))

__device__ __forceinline__ unsigned xb_ld(unsigned* p)              { return __hip_atomic_load(p, __ATOMIC_RELAXED, __HIP_MEMORY_SCOPE_AGENT); }
__device__ __forceinline__ unsigned xb_add(unsigned* p, unsigned v) { return __hip_atomic_fetch_add(p, v, __ATOMIC_RELAXED, __HIP_MEMORY_SCOPE_AGENT); }
__device__ __forceinline__ unsigned xb_xcc_id() { return (unsigned)__builtin_amdgcn_s_getreg((3 << 11) | 20) & 0xFu; }
#define XB_SPIN(cond, bar) do { unsigned _sp = 0; while (cond) { __builtin_amdgcn_s_sleep(1); \
    if ((++_sp & 255u) == 0u) { if (xb_ld(&(bar)[XB_TMO])) break; if (_sp > XB_SPIN_CAP) { atomicAdd(&(bar)[XB_TMO], 1u); break; } } } } while (0)

struct XcdBarrier {
    unsigned* bar; unsigned x;
    volatile LAS unsigned* st;
};

__device__ __forceinline__ XcdBarrier xcd_barrier_post(unsigned* bar, volatile LAS unsigned* st) {
    XcdBarrier b; b.bar = bar; b.x = xb_xcc_id(); b.st = st;
    if (threadIdx.x == 0) (void)xb_add(&bar[XB_XCNT(b.x)], 1u);
    return b;
}
__device__ __forceinline__ void xcd_barrier_complete(unsigned* bar, unsigned x, unsigned& nloc, unsigned& nx) {
    const unsigned G = gridDim.x * gridDim.y * gridDim.z;
    unsigned sum, cnt, mine, sp = 0u;
    for (;;) {
        sum = 0u; cnt = 0u; mine = 0u;
#pragma unroll
        for (unsigned j = 0; j < 16; ++j) { const unsigned c = xb_ld(&bar[XB_XCNT(j)]); sum += c; cnt += (c > 0u) ? 1u : 0u; mine = (j == x) ? c : mine; }
        if (sum == G) break;
        __builtin_amdgcn_s_sleep(1);
        if ((++sp & 255u) == 0u) { if (xb_ld(&bar[XB_TMO])) break; if (sp > XB_SPIN_CAP) { atomicAdd(&bar[XB_TMO], 1u); break; } }
    }
    nloc = mine > 0u ? mine : 1u; nx = cnt > 0u ? cnt : 1u;
}

__device__ __forceinline__ void xcd_barrier(const XcdBarrier& b) {
    asm volatile("s_waitcnt vmcnt(0)" ::: "memory");
    __syncthreads();
    if (threadIdx.x == 0) {
        unsigned* bar = b.bar;
        __builtin_amdgcn_s_waitcnt(0);
        unsigned nloc = b.st[0], nx = b.st[1];
        if (nloc == 0u) { xcd_barrier_complete(bar, b.x, nloc, nx); b.st[0] = nloc; b.st[1] = nx; }
        const unsigned old = xb_add(&bar[XB_XSUB(b.x)], 1u);
        const unsigned gen = old / nloc;
        if (old + 1u == (gen + 1u) * nloc) {
            __builtin_amdgcn_fence(__ATOMIC_RELEASE, "agent");
            asm volatile("s_waitcnt vmcnt(0)" ::: "memory");
            const unsigned og = xb_add(&bar[XB_TOP], 1u);
            const unsigned tg = og / nx;
            if (og + 1u == (tg + 1u) * nx) xb_add(&bar[XB_TOPGEN], 1u);
            else XB_SPIN(xb_ld(&bar[XB_TOPGEN]) == tg, bar);
            __builtin_amdgcn_fence(__ATOMIC_ACQUIRE, "agent");
            xb_add(&bar[XB_XGEN(b.x)], 1u);
            asm volatile("s_waitcnt vmcnt(0)" ::: "memory");
        } else {
            XB_SPIN(xb_ld(&bar[XB_XGEN(b.x)]) == gen, bar);
            __builtin_amdgcn_fence(__ATOMIC_ACQUIRE, "agent");
            asm volatile("s_waitcnt vmcnt(0)" ::: "memory");
        }
    }
    __syncthreads();
}


using pg8::bf16_t; using pg8::f32x4; using pg8::u32x4; using pg8::Unit; using pg8::cvt_pk_bf16;
typedef unsigned u32x2 __attribute__((ext_vector_type(2)));
struct Args { const float* in[20]; float* out; unsigned char* ws; };
enum { I_XP = 0, I_XS, I_CK, I_CV, I_C, I_CCTX, I_WMOD, I_BMOD, I_WIN, I_QG, I_KG, I_WPOOL, I_PSCALE, I_WOUT, I_LN1G, I_LN1B, I_WFF1, I_WFF2, I_LN2G, I_LN2B };

template <int CTRL> __device__ __forceinline__ float dpp_f(float v) { return __int_as_float(__builtin_amdgcn_update_dpp(0, __float_as_int(v), CTRL, 0xF, 0xF, true)); }
__device__ __forceinline__ float wave_sum(float v) {
    v += dpp_f<0xB1>(v); v += dpp_f<0x4E>(v); v += dpp_f<0x141>(v); v += dpp_f<0x140>(v);
    { auto r = __builtin_amdgcn_permlane16_swap(__float_as_uint(v), __float_as_uint(v), false, false); v = __uint_as_float(r[0]) + __uint_as_float(r[1]); }
    { auto r = __builtin_amdgcn_permlane32_swap(__float_as_uint(v), __float_as_uint(v), false, false); v = __uint_as_float(r[0]) + __uint_as_float(r[1]); }
    return v;
}
__device__ __forceinline__ float bf_lo(unsigned w) { return __uint_as_float(w << 16); }
__device__ __forceinline__ float bf_hi(unsigned w) { return __uint_as_float(w & 0xffff0000u); }
__device__ __forceinline__ int mod_row_of(int row) { return row < MCTX ? 4 : ((row - MCTX) >> 12); }
__device__ __forceinline__ const float* x_row(const Args& a, int row) { return row < MCTX ? a.in[I_XP] + (size_t)row * DM : a.in[I_XS] + (size_t)(row - MCTX) * DM; }

template <int ACT  , bool CS  > struct EpiB {
    static constexpr bool PERM = true, AFTER_DRAIN = false;
    bf16_t* O; int ldc; const float* cs;
    __device__ __forceinline__ void operator()(const f32x4 (&acc)[2][2][4][2], const Unit& u, int wr, int wc, int fr, int fq) const {
        const int row0 = u.pm * 256 + wr * 64 + fr, col0 = u.pn * 256 + wc * 32 + 8 * fq;
#pragma unroll
        for (int bj = 0; bj < 2; ++bj) {
            f32x4 sv0 = {1.f, 1.f, 1.f, 1.f}, sv1 = sv0;
            if (CS) { sv0 = *(const f32x4*)(cs + col0 + bj * 128); sv1 = *(const f32x4*)(cs + col0 + bj * 128 + 4); }
#pragma unroll
            for (int ai = 0; ai < 2; ++ai)
#pragma unroll
                for (int m = 0; m < 4; ++m) { bf16_t* rowp = O + (size_t)(row0 + ai * 128 + m * 16) * ldc + col0 + bj * 128;
                    f32x4 v0 = acc[ai][bj][m][0], v1 = acc[ai][bj][m][1];
                    if (ACT == 1) {
#pragma unroll
                        for (int j = 0; j < 4; ++j) { const float r0 = fmaxf(v0[j], 0.f), r1 = fmaxf(v1[j], 0.f); v0[j] = r0 * r0; v1[j] = r1 * r1; } }
                    if (CS) { v0 = v0 * sv0; v1 = v1 * sv1; }
                    u32x4 w; w.x = cvt_pk_bf16(v0[0], v0[1]); w.y = cvt_pk_bf16(v0[2], v0[3]); w.z = cvt_pk_bf16(v1[0], v1[1]); w.w = cvt_pk_bf16(v1[2], v1[3]);
                    if (ACT == 1) __builtin_nontemporal_store(w, (u32x4*)rowp); else *(u32x4*)rowp = w; }
            asm volatile("" ::: "memory");
        }
    }
};
struct EpiPre1 {
    static constexpr bool PERM = true, AFTER_DRAIN = false;
    const float* __restrict__ xp; const float* __restrict__ xs; bf16_t* __restrict__ pre; const float* __restrict__ gate;
    __device__ __forceinline__ void operator()(const f32x4 (&acc)[2][2][4][2], const Unit& u, int wr, int wc, int fr, int fq) const {
        const int row0 = u.pm * 256 + wr * 64 + fr, col0 = u.pn * 256 + wc * 32 + 8 * fq;
        const int mrow = u.pm < 16 ? 4 : ((u.pm - 16) >> 4);
        const float* gp = gate + (size_t)mrow * NMOD + col0;
        f32x4 gv[2][2];
#pragma unroll
        for (int bj = 0; bj < 2; ++bj)
#pragma unroll
            for (int n = 0; n < 2; ++n) gv[bj][n] = *(const f32x4*)(gp + bj * 128 + n * 4);
#pragma unroll
        for (int ai = 0; ai < 2; ++ai) {
            f32x4 xv[4][2][2];
#pragma unroll
            for (int m = 0; m < 4; ++m) { const int row = row0 + ai * 128 + m * 16;
                const float* xr = (row < MCTX ? xp + (size_t)row * DM : xs + (size_t)(row - MCTX) * DM) + col0;
#pragma unroll
                for (int bj = 0; bj < 2; ++bj)
#pragma unroll
                    for (int n = 0; n < 2; ++n) xv[m][bj][n] = *(const f32x4*)(xr + bj * 128 + n * 4); }
#pragma unroll
            for (int m = 0; m < 4; ++m) { bf16_t* prow = pre + (size_t)(row0 + ai * 128 + m * 16) * DM + col0;
#pragma unroll
                for (int bj = 0; bj < 2; ++bj) { const f32x4 v0 = xv[m][bj][0] * ALPHA + gv[bj][0] * acc[ai][bj][m][0], v1 = xv[m][bj][1] * ALPHA + gv[bj][1] * acc[ai][bj][m][1];
                    u32x4 w; w.x = cvt_pk_bf16(v0[0], v0[1]); w.y = cvt_pk_bf16(v0[2], v0[3]); w.z = cvt_pk_bf16(v1[0], v1[1]); w.w = cvt_pk_bf16(v1[2], v1[3]);
                    *(u32x4*)(prow + bj * 128) = w; } }
            asm volatile("" ::: "memory");
        }
    }
};
struct EpiPre2 {
    static constexpr bool PERM = true, AFTER_DRAIN = false;
    const bf16_t* __restrict__ pre1; const float* __restrict__ stats; const float* __restrict__ g1; const float* __restrict__ b1; bf16_t* __restrict__ pre2; const float* __restrict__ gate; bf16_t* __restrict__ part;
    __device__ __forceinline__ void operator()(const f32x4 (&acc)[2][2][4][2], const Unit& u, int wr, int wc, int fr, int fq) const {
        int pn_l = u.pn; asm volatile("" : "+s"(pn_l));
        const int row0 = u.pm * 256 + wr * 64 + fr, col0 = pn_l * 256 + wc * 32 + 8 * fq;
        const int mrow = u.pm < 16 ? 4 : ((u.pm - 16) >> 4);
        const float* gp = gate + (size_t)mrow * NMOD + col0;
        f32x4 gv[2][2];
#pragma unroll
        for (int bj = 0; bj < 2; ++bj)
#pragma unroll
            for (int n = 0; n < 2; ++n) gv[bj][n] = *(const f32x4*)(gp + bj * 128 + n * 4);
        if (u.ks) {
#pragma unroll
            for (int ai = 0; ai < 2; ++ai)
#pragma unroll
                for (int m = 0; m < 4; ++m) { bf16_t* prow = part + (size_t)(row0 + ai * 128 + m * 16 - 16384) * DM + col0;
#pragma unroll
                    for (int bj = 0; bj < 2; ++bj) { const f32x4 v0 = gv[bj][0] * acc[ai][bj][m][0], v1 = gv[bj][1] * acc[ai][bj][m][1];
                        u32x4 w; w.x = cvt_pk_bf16(v0[0], v0[1]); w.y = cvt_pk_bf16(v0[2], v0[3]); w.z = cvt_pk_bf16(v1[0], v1[1]); w.w = cvt_pk_bf16(v1[2], v1[3]);
                        *(u32x4*)(prow + bj * 128) = w; } }
            return;
        }
        f32x4 lg[2][2], lb[2][2];
#pragma unroll
        for (int bj = 0; bj < 2; ++bj)
#pragma unroll
            for (int n = 0; n < 2; ++n) { lg[bj][n] = *(const f32x4*)(g1 + col0 + bj * 128 + n * 4); lb[bj][n] = *(const f32x4*)(b1 + col0 + bj * 128 + n * 4); }
#pragma unroll
        for (int ai = 0; ai < 2; ++ai) {
            u32x4 pv[4][2]; float2 st[4];
#pragma unroll
            for (int m = 0; m < 4; ++m) { const int row = row0 + ai * 128 + m * 16;
                st[m] = *(const float2*)(stats + (size_t)row * 2);
#pragma unroll
                for (int bj = 0; bj < 2; ++bj) pv[m][bj] = *(const u32x4*)(pre1 + (size_t)row * DM + col0 + bj * 128); }
#pragma unroll
            for (int m = 0; m < 4; ++m) { bf16_t* orow = pre2 + (size_t)(row0 + ai * 128 + m * 16) * DM + col0;
                const float mu = st[m].x, rs = st[m].y;
#pragma unroll
                for (int bj = 0; bj < 2; ++bj) { const u32x4 p = pv[m][bj];
                    const f32x4 p0 = {bf_lo(p.x), bf_hi(p.x), bf_lo(p.y), bf_hi(p.y)}, p1 = {bf_lo(p.z), bf_hi(p.z), bf_lo(p.w), bf_hi(p.w)};
                    const f32x4 x0 = (p0 - mu) * rs * lg[bj][0] + lb[bj][0], x1 = (p1 - mu) * rs * lg[bj][1] + lb[bj][1];
                    const f32x4 v0 = x0 * ALPHA + gv[bj][0] * acc[ai][bj][m][0], v1 = x1 * ALPHA + gv[bj][1] * acc[ai][bj][m][1];
                    u32x4 w; w.x = cvt_pk_bf16(v0[0], v0[1]); w.y = cvt_pk_bf16(v0[2], v0[3]); w.z = cvt_pk_bf16(v1[0], v1[1]); w.w = cvt_pk_bf16(v1[2], v1[3]);
                    *(u32x4*)(orow + bj * 128) = w; } }
            asm volatile("" ::: "memory");
        }
    }
};
struct SplitOrder {
    int c;
    __device__ __forceinline__ bool next(int i, Unit& u) const {
        const int xcd = c & 7, offc = c >> 3;
        const bool rem = (i == 2);
        const int pmv = 4 * xcd + (offc & 3);
        const int ks = pmv >> 4;
        u.pm = rem ? 64 + (pmv & 15) : 8 * xcd + 4 * i + (offc & 3);
        u.pn = offc >> 2;
        u.ks = rem ? ks : 0; u.kt0 = rem ? ks * (DFF / 128) : 0; u.nkt = rem ? (DFF / 128) : (DFF / 64);
        return i <= 2;
    }
    __device__ __forceinline__ void a_ready(const Unit&) const {}
    __device__ __forceinline__ void done(const Unit&) const {}
};

__device__ __forceinline__ void transpose_piece(const float* __restrict__ W, int Krows, int Ncols, bf16_t* __restrict__ WT, int kt, int nt, int lane) {
    const int nq = lane >> 3, kg = lane & 7;
    const float* src = W + (size_t)(kt * 64 + kg * 8) * Ncols + nt * 32 + nq * 4;
    f32x4 r[8];
#pragma unroll
    for (int i = 0; i < 8; ++i) r[i] = __builtin_nontemporal_load((const f32x4*)(src + (size_t)i * Ncols));
    bf16_t* dst = WT + (size_t)(nt * 32 + nq * 4) * Krows + kt * 64 + kg * 8;
#pragma unroll
    for (int j = 0; j < 4; ++j) { u32x4 w; w.x = cvt_pk_bf16(r[0][j], r[1][j]); w.y = cvt_pk_bf16(r[2][j], r[3][j]); w.z = cvt_pk_bf16(r[4][j], r[5][j]); w.w = cvt_pk_bf16(r[6][j], r[7][j]);
        *(u32x4*)(dst + (size_t)j * Krows) = w; }
}
constexpr int T_WIN = 32 * 80, T_WOUT = 32 * 64, T_FF1 = 32 * 256, T_FF2 = 128 * 64;
__device__ __forceinline__ void transpose_item(const Args& a, int it, int lane) {
    unsigned char* ws = a.ws;
    if (it < T_WIN) { transpose_piece(a.in[I_WIN], DM, NIN, (bf16_t*)(ws + WS_WIN), it / 80, it % 80, lane); return; }
    it -= T_WIN;
    if (it < T_WOUT) { transpose_piece(a.in[I_WOUT], DM, DM, (bf16_t*)(ws + WS_WOUT), it / 64, it % 64, lane); return; }
    it -= T_WOUT;
    if (it < T_FF1) { transpose_piece(a.in[I_WFF1], DM, DFF, (bf16_t*)(ws + WS_WFF1), it / 256, it % 256, lane); return; }
    it -= T_FF1;
    if (it < T_FF2) { transpose_piece(a.in[I_WFF2], DFF, DM, (bf16_t*)(ws + WS_WFF2), it / 64, it % 64, lane); return; }
    it -= T_FF2;
    { const int g = it >> 5, tt = it & 31; transpose_piece(a.in[I_WPOOL] + (size_t)g * 65536, 256, 256, (bf16_t*)(ws + WS_WPOOL) + (size_t)g * 65536, tt >> 3, tt & 7, lane); }
}
constexpr int N_TITEMS = 32 * 80 + 32 * 64 + 32 * 256 + 128 * 64 + 128;
__device__ __forceinline__ void mod_job(const Args& a, int job, float* __restrict__ mod, float* lds) {
    float* sil = lds; float* red = lds + 5 * DM;
    const int t = threadIdx.x;
    for (int i = t; i < 5 * DM; i += 512) { const float x = (i < 4 * DM) ? a.in[I_C][i] : a.in[I_CCTX][i - 4 * DM]; sil[i] = x / (1.f + __expf(-x)); }
    __syncthreads();
    const int cg4 = t & 15, ch = t >> 4, col0 = job * 64 + cg4 * 4;
    f32x4 a0 = {0.f, 0.f, 0.f, 0.f}, a1 = a0, a2 = a0, a3 = a0, a4 = a0;
    const float* wp = a.in[I_WMOD] + (size_t)(ch * 64) * NMOD + col0;
#pragma unroll 16
    for (int i = 0; i < 64; ++i) { const f32x4 w = __builtin_nontemporal_load((const f32x4*)(wp + (size_t)i * NMOD)); const int d = ch * 64 + i;
        a0 += w * sil[d]; a1 += w * sil[DM + d]; a2 += w * sil[2 * DM + d]; a3 += w * sil[3 * DM + d]; a4 += w * sil[4 * DM + d]; }
    *(f32x4*)(red + (ch * 5 + 0) * 64 + cg4 * 4) = a0; *(f32x4*)(red + (ch * 5 + 1) * 64 + cg4 * 4) = a1; *(f32x4*)(red + (ch * 5 + 2) * 64 + cg4 * 4) = a2;
    *(f32x4*)(red + (ch * 5 + 3) * 64 + cg4 * 4) = a3; *(f32x4*)(red + (ch * 5 + 4) * 64 + cg4 * 4) = a4;
    __syncthreads();
    if (t < 320) { const int r = t >> 6, col = t & 63; float s = 0.f;
#pragma unroll 8
        for (int c = 0; c < 32; ++c) s += red[(c * 5 + r) * 64 + col];
        mod[(size_t)r * NMOD + job * 64 + col] = s + a.in[I_BMOD][job * 64 + col]; }
    __syncthreads();
}
__device__ __forceinline__ void slack_transposes(const Args& a, int lo, int hi, int first_wg) {
    int tid_l = threadIdx.x; asm volatile("" : "+v"(tid_l));
    const int lane = tid_l & 63, wid = tid_l >> 6, bid = blockIdx.x;
    if (bid < first_wg) return;
    for (int it = lo + (bid - first_wg) * 8 + wid; it < hi; it += (256 - first_wg) * 8) transpose_item(a, it, lane);
}
__device__ void phase_prep(const Args& a, float* lds) {
    unsigned char* ws = a.ws;
    float* mod = (float*)(ws + WS_MOD);
    int tid_l = threadIdx.x; asm volatile("" : "+v"(tid_l));
    const int lane = tid_l & 63, wid = tid_l >> 6, G = gridDim.x, bid = blockIdx.x;
    constexpr int J_MOD = NMOD / 64;
    if (G == 256) {
        if (bid < J_MOD) mod_job(a, bid, mod, lds);
        else { for (int it = (bid - J_MOD) * 8 + wid; it < T_WIN; it += 64 * 8) transpose_item(a, it, lane);
               for (int it = N_TITEMS - 128 + (bid - J_MOD) * 8 + wid; it < N_TITEMS; it += 64 * 8) transpose_item(a, it, lane); }
    } else {
        for (int job = bid; job < J_MOD; job += G) mod_job(a, job, mod, lds);
        for (int it = bid * 8 + wid; it < N_TITEMS; it += G * 8) transpose_item(a, it, lane);
    }
    bf16_t* klat = (bf16_t*)(ws + WS_KLAT); bf16_t* vlat = (bf16_t*)(ws + WS_VLAT);
    constexpr int NC8 = 4 * 512 * 256 / 8;
    for (int i = bid * 512 + tid_l; i < 2 * NC8; i += G * 512) {
        const bool isk = i < NC8; const int e = (isk ? i : i - NC8) * 8;
        const float* src = (isk ? a.in[I_CK] : a.in[I_CV]) + e;
        const f32x4 v0 = *(const f32x4*)src, v1 = *(const f32x4*)(src + 4);
        const int b = e / (512 * 256), rem = e % (512 * 256);
        bf16_t* dst = (isk ? klat : vlat) + (size_t)b * SKV_LAT * 256 + rem;
        u32x4 w; w.x = cvt_pk_bf16(v0[0], v0[1]); w.y = cvt_pk_bf16(v0[2], v0[3]); w.z = cvt_pk_bf16(v1[0], v1[1]); w.w = cvt_pk_bf16(v1[2], v1[3]);
        *(u32x4*)dst = w;
    }
    float* ropeC = (float*)(ws + WS_ROPE); float* ropeS = ropeC + 2048;
    for (int i = bid * 512 + tid_l; i < 2048; i += G * 512) { const int pos = i >> 5, fi = i & 31;
        const float inv = exp2f(-(float)fi * (13.287712379549449f / 32.f)); const float ang = (float)pos * inv;
        ropeC[i] = cosf(ang); ropeS[i] = sinf(ang); }
}

__device__ __forceinline__ void row_stats(const f32x4 (&v)[8], float& mu, float& rstd) {
    float s = 0.f;
#pragma unroll
    for (int i = 0; i < 8; ++i) s += (v[i][0] + v[i][1]) + (v[i][2] + v[i][3]);
    s = wave_sum(s); mu = s * (1.f / DM);
    float q = 0.f;
#pragma unroll
    for (int i = 0; i < 8; ++i) { const f32x4 d = v[i] - mu; q += (d[0] * d[0] + d[1] * d[1]) + (d[2] * d[2] + d[3] * d[3]); }
    q = wave_sum(q); rstd = 1.0f / sqrtf(q * (1.f / DM) + LN_EPS);
}
#define LD8(dst, p) do { _Pragma("unroll") for (int _i = 0; _i < 8; ++_i) dst[_i] = *(const f32x4*)((p) + _i * 256 + lane * 4); } while (0)
__device__ __forceinline__ void ln_in_row(const f32x4 (&v)[8], const f32x4 (&sh)[8], const f32x4 (&sc)[8], bf16_t* __restrict__ urow, int lane) {
    float mu, rstd; row_stats(v, mu, rstd);
#pragma unroll
    for (int i = 0; i < 8; ++i) { const int col = i * 256 + lane * 4;
        const f32x4 o = (v[i] - mu) * rstd * (sc[i] + 1.0f) + sh[i];
        u32x2 w; w.x = cvt_pk_bf16(o[0], o[1]); w.y = cvt_pk_bf16(o[2], o[3]);
        *(u32x2*)(urow + col) = w; }
}
__device__ void phase_ln_in(const Args& a) {
    int tid_l = threadIdx.x; asm volatile("" : "+v"(tid_l));
    const int lane = tid_l & 63, wid = tid_l >> 6;
    const float* __restrict__ mod = (const float*)(a.ws + WS_MOD); bf16_t* __restrict__ U = (bf16_t*)(a.ws + WS_ACT);
    const int stride = gridDim.x * 8; int row = blockIdx.x * 8 + wid;
    f32x4 nx0[8], nx1[8];
    if (row < MTOT) { LD8(nx0, x_row(a, row)); LD8(nx1, x_row(a, min(row + stride, MTOT - 1))); }
    for (; row < MTOT; row += 2 * stride) {
        const int row1 = row + stride;
        f32x4 v0[8], v1[8], sh[8], sc[8];
        const int mr0 = mod_row_of(row);
        { const float* mp = mod + (size_t)mr0 * NMOD; LD8(sh, mp); LD8(sc, mp + DM); }
#pragma unroll
        for (int i = 0; i < 8; ++i) { v0[i] = nx0[i]; v1[i] = nx1[i]; }
        LD8(nx0, x_row(a, min(row + 2 * stride, MTOT - 1))); LD8(nx1, x_row(a, min(row + 3 * stride, MTOT - 1)));
        ln_in_row(v0, sh, sc, U + (size_t)row * DM, lane);
        if (row1 < MTOT) {
            const int mr1 = mod_row_of(row1);
            if (mr1 != mr0) { const float* mp = mod + (size_t)mr1 * NMOD; LD8(sh, mp); LD8(sc, mp + DM); }
            ln_in_row(v1, sh, sc, U + (size_t)row1 * DM, lane);
        }
    }
}
__device__ __forceinline__ void ld_row_bf16(const bf16_t* __restrict__ p, int lane, u32x4 (&w)[4]) {
#pragma unroll
    for (int i = 0; i < 4; ++i) w[i] = *(const u32x4*)(p + i * 512 + lane * 8);
}
__device__ __forceinline__ void unpack_row(const u32x4 (&w)[4], float (&v)[32]) {
#pragma unroll
    for (int i = 0; i < 4; ++i) { v[8 * i + 0] = bf_lo(w[i].x); v[8 * i + 1] = bf_hi(w[i].x); v[8 * i + 2] = bf_lo(w[i].y); v[8 * i + 3] = bf_hi(w[i].y);
        v[8 * i + 4] = bf_lo(w[i].z); v[8 * i + 5] = bf_hi(w[i].z); v[8 * i + 6] = bf_lo(w[i].w); v[8 * i + 7] = bf_hi(w[i].w); }
}
__device__ __forceinline__ void ld_vec32(const float* __restrict__ p, int lane, float (&g)[32]) {
#pragma unroll
    for (int i = 0; i < 4; ++i) { const f32x4 a = *(const f32x4*)(p + i * 512 + lane * 8), b = *(const f32x4*)(p + i * 512 + lane * 8 + 4);
#pragma unroll
        for (int e = 0; e < 4; ++e) { g[8 * i + e] = a[e]; g[8 * i + 4 + e] = b[e]; } }
}
__device__ __forceinline__ void stats32(const float (&v)[32], float& mu, float& rstd) {
    float s = 0.f;
#pragma unroll
    for (int i = 0; i < 32; ++i) s += v[i];
    s = wave_sum(s); mu = s * (1.f / DM);
    float q = 0.f;
#pragma unroll
    for (int i = 0; i < 32; ++i) { const float d = v[i] - mu; q += d * d; }
    q = wave_sum(q); rstd = 1.0f / sqrtf(q * (1.f / DM) + LN_EPS);
}
__device__ __forceinline__ void ln_mid_row(const u32x4 (&raw)[4], const float (&g)[32], const float (&b)[32], const float (&sh)[32], const float (&sc)[32], float* __restrict__ st, bf16_t* __restrict__ urow, int lane) {
    float v[32]; unpack_row(raw, v);
    float mu, rstd; stats32(v, mu, rstd);
    if (lane == 0) { float2 s2; s2.x = mu; s2.y = rstd; *(float2*)st = s2; }
#pragma unroll
    for (int i = 0; i < 32; ++i) v[i] = (v[i] - mu) * rstd * g[i] + b[i];
    float mu2, rstd2; stats32(v, mu2, rstd2);
#pragma unroll
    for (int i = 0; i < 4; ++i) { float o[8];
#pragma unroll
        for (int e = 0; e < 8; ++e) o[e] = (v[8 * i + e] - mu2) * rstd2 * (sc[8 * i + e] + 1.0f) + sh[8 * i + e];
        u32x4 w; w.x = cvt_pk_bf16(o[0], o[1]); w.y = cvt_pk_bf16(o[2], o[3]); w.z = cvt_pk_bf16(o[4], o[5]); w.w = cvt_pk_bf16(o[6], o[7]);
        *(u32x4*)(urow + i * 512 + lane * 8) = w; }
}
__device__ void phase_ln_mid(const Args& a) {
    int tid_l = threadIdx.x; asm volatile("" : "+v"(tid_l));
    const int lane = tid_l & 63, wid = tid_l >> 6;
    const float* __restrict__ mod = (const float*)(a.ws + WS_MOD); bf16_t* __restrict__ U = (bf16_t*)(a.ws + WS_ACT);
    const bf16_t* __restrict__ pre1 = (const bf16_t*)a.out; float* __restrict__ stats = (float*)(a.ws + WS_STATS);
    const int stride = gridDim.x * 8; int row = blockIdx.x * 8 + wid;
    float g[32], b[32]; ld_vec32(a.in[I_LN1G], lane, g); ld_vec32(a.in[I_LN1B], lane, b);
    u32x4 nx0[4], nx1[4];
    if (row < MTOT) { ld_row_bf16(pre1 + (size_t)row * DM, lane, nx0); ld_row_bf16(pre1 + (size_t)min(row + stride, MTOT - 1) * DM, lane, nx1); }
    for (; row < MTOT; row += 2 * stride) {
        const int row1 = row + stride;
        float sh[32], sc[32];
        const int mr0 = mod_row_of(row);
        { const float* mp = mod + (size_t)mr0 * NMOD + 3 * DM; ld_vec32(mp, lane, sh); ld_vec32(mp + DM, lane, sc); }
        u32x4 c0[4], c1[4];
#pragma unroll
        for (int i = 0; i < 4; ++i) { c0[i] = nx0[i]; c1[i] = nx1[i]; }
        ld_row_bf16(pre1 + (size_t)min(row + 2 * stride, MTOT - 1) * DM, lane, nx0); ld_row_bf16(pre1 + (size_t)min(row + 3 * stride, MTOT - 1) * DM, lane, nx1);
        ln_mid_row(c0, g, b, sh, sc, stats + (size_t)row * 2, U + (size_t)row * DM, lane);
        if (row1 < MTOT) {
            const int mr1 = mod_row_of(row1);
            if (mr1 != mr0) { const float* mp = mod + (size_t)mr1 * NMOD + 3 * DM; ld_vec32(mp, lane, sh); ld_vec32(mp + DM, lane, sc); }
            ln_mid_row(c1, g, b, sh, sc, stats + (size_t)row1 * 2, U + (size_t)row1 * DM, lane);
        }
    }
}
__device__ __forceinline__ void ln_out_row(const u32x4 (&raw)[4], const u32x4 (&praw)[4], bool has_part, const float (&g)[32], const float (&b)[32], float* __restrict__ orow, int lane) {
    float v[32]; unpack_row(raw, v);
    if (has_part) { float pp[32]; unpack_row(praw, pp);
#pragma unroll
        for (int i = 0; i < 32; ++i) v[i] += pp[i]; }
    float mu, rstd; stats32(v, mu, rstd);
#pragma unroll
    for (int i = 0; i < 4; ++i) { f32x4 o0, o1;
#pragma unroll
        for (int e = 0; e < 4; ++e) { o0[e] = (v[8 * i + e] - mu) * rstd * g[8 * i + e] + b[8 * i + e]; o1[e] = (v[8 * i + 4 + e] - mu) * rstd * g[8 * i + 4 + e] + b[8 * i + 4 + e]; }
        float* op = orow + i * 512 + lane * 8;
        *(f32x4*)op = o0; *(f32x4*)(op + 4) = o1; }
}
__device__ void phase_ln_out(const Args& a, const bf16_t* __restrict__ pre2, const bf16_t* __restrict__ part) {
    int tid_l = threadIdx.x; asm volatile("" : "+v"(tid_l));
    const int lane = tid_l & 63, wid = tid_l >> 6;
    float* __restrict__ out = a.out;
    const int stride = gridDim.x * 8; int row = blockIdx.x * 8 + wid;
    float g[32], b[32]; ld_vec32(a.in[I_LN2G], lane, g); ld_vec32(a.in[I_LN2B], lane, b);
    u32x4 nx0[4], nx1[4], np0[4], np1[4];
#pragma unroll
    for (int i = 0; i < 4; ++i) { np0[i] = (u32x4){0u, 0u, 0u, 0u}; np1[i] = np0[i]; }
#define LDROWP(nx, np, r) do { const int r_ = min((r), MTOT - 1); ld_row_bf16(pre2 + (size_t)r_ * DM, lane, nx); if (part && r_ >= 16384) ld_row_bf16(part + (size_t)(r_ - 16384) * DM, lane, np); } while (0)
    if (row < MTOT) { LDROWP(nx0, np0, row); LDROWP(nx1, np1, row + stride); }
    for (; row < MTOT; row += 2 * stride) {
        const int row1 = row + stride;
        u32x4 c0[4], c1[4], p0[4], p1[4];
#pragma unroll
        for (int i = 0; i < 4; ++i) { c0[i] = nx0[i]; c1[i] = nx1[i]; p0[i] = np0[i]; p1[i] = np1[i]; }
        LDROWP(nx0, np0, row + 2 * stride); LDROWP(nx1, np1, row + 3 * stride);
        ln_out_row(c0, p0, part && row >= 16384, g, b, out + (size_t)row * DM, lane);
        if (row1 < MTOT) ln_out_row(c1, p1, part && row1 >= 16384, g, b, out + (size_t)row1 * DM, lane);
    }
#undef LDROWP
}

__device__ __forceinline__ float row16_sum(float v) { v += dpp_f<0xB1>(v); v += dpp_f<0x4E>(v); v += dpp_f<0x141>(v); v += dpp_f<0x140>(v); return v; }
__device__ __forceinline__ float lane_xor4(float v) { return dpp_f<0x1B>(dpp_f<0x141>(v)); }
__device__ __forceinline__ void unpack8(const u32x4 w, float (&x)[8]) { x[0] = bf_lo(w.x); x[1] = bf_hi(w.x); x[2] = bf_lo(w.y); x[3] = bf_hi(w.y); x[4] = bf_lo(w.z); x[5] = bf_hi(w.z); x[6] = bf_lo(w.w); x[7] = bf_hi(w.w); }
__device__ __forceinline__ u32x4 pack8(const float (&x)[8]) { u32x4 w; w.x = cvt_pk_bf16(x[0], x[1]); w.y = cvt_pk_bf16(x[2], x[3]); w.z = cvt_pk_bf16(x[4], x[5]); w.w = cvt_pk_bf16(x[6], x[7]); return w; }
__device__ __forceinline__ void norm_rope8(float (&x)[8], const float (&gn)[8], const float (&cs)[8], const float (&sn)[8], bool lat) {
    float ss = 0.f;
#pragma unroll
    for (int e = 0; e < 8; ++e) ss += x[e] * x[e];
    ss = row16_sum(ss); const float rinv = 1.0f / sqrtf(ss * (1.f / 128.f) + LN_EPS);
#pragma unroll
    for (int e = 0; e < 8; ++e) x[e] = x[e] * rinv * gn[e];
    if (lat) {
#pragma unroll
        for (int e = 0; e < 8; ++e) { const float p = lane_xor4(x[e]); x[e] = x[e] * cs[e] + p * sn[e]; } }
}
__device__ void phase_elem(const Args& a) {
    int tid_l = threadIdx.x; asm volatile("" : "+v"(tid_l));
    const int lane = tid_l & 63, wid = tid_l >> 6;
    unsigned char* ws = a.ws;
    const bf16_t* __restrict__ PROJ = (const bf16_t*)(ws + WS_PROJ);
    bf16_t* __restrict__ KL = (bf16_t*)(ws + WS_KLAT); bf16_t* __restrict__ VL = (bf16_t*)(ws + WS_VLAT);
    bf16_t* __restrict__ KC = (bf16_t*)(ws + WS_KCTX); bf16_t* __restrict__ VC = (bf16_t*)(ws + WS_VCTX);
    const float* __restrict__ ropeC = (const float*)(ws + WS_ROPE); const float* __restrict__ ropeS = ropeC + 2048;
    float* __restrict__ ctxk = a.out + (size_t)MTOT * DM; float* __restrict__ ctxv = ctxk + (size_t)MCTX * 256;
    const int j16 = lane & 15; const bool colpart = j16 >= 8, second = (j16 & 4) != 0; const int f0 = 8 * (j16 & 3);
    float kg[8];
#pragma unroll
    for (int e = 0; e < 8; ++e) kg[e] = a.in[I_KG][8 * j16 + e];
    const int stride = gridDim.x * 8;
    for (int base = blockIdx.x * 8 + wid; base < MTOT; base += 5 * stride) {
        u32x4 c2[5]; f32x4 ca[5], cb[5], sa[5], sb[5];
#pragma unroll
        for (int k = 0; k < 5; ++k) { const int tk = min(base + k * stride, MTOT - 1);
            c2[k] = *(const u32x4*)(PROJ + (size_t)tk * NIN + 1024 + lane * 8);
            const bool latk = tk >= MCTX; const int sk = (tk - MCTX) & 4095;
            const int pos = latk ? (colpart ? (sk & 63) : (sk >> 6)) : 0;
            ca[k] = *(const f32x4*)(ropeC + pos * 32 + f0); cb[k] = *(const f32x4*)(ropeC + pos * 32 + f0 + 4); sa[k] = *(const f32x4*)(ropeS + pos * 32 + f0); sb[k] = *(const f32x4*)(ropeS + pos * 32 + f0 + 4); }
#pragma unroll
        for (int k = 0; k < 5; ++k) { const int tok = base + k * stride;
            if (tok < MTOT) {
                const bool lat = tok >= MCTX;
                int b, s; if (!lat) { b = tok >> 8; s = tok & 255; } else { const int tt = tok - MCTX; b = tt >> 12; s = tt & 4095; }
                float cs[8], sn[8];
#pragma unroll
                for (int e = 0; e < 4; ++e) { cs[e] = ca[k][e]; cs[4 + e] = cb[k][e]; sn[e] = second ? sa[k][e] : -sa[k][e]; sn[4 + e] = second ? sb[k][e] : -sb[k][e]; }
                float x2[8]; unpack8(c2[k], x2);
                float x2n[8];
#pragma unroll
                for (int e = 0; e < 8; ++e) x2n[e] = x2[e];
                norm_rope8(x2n, kg, cs, sn, lat);
                const bool isk = lane < 32;
                float kv[8];
#pragma unroll
                for (int e = 0; e < 8; ++e) kv[e] = isk ? x2n[e] : x2[e];
                const u32x4 kvw = pack8(kv);
                const int off = (lane & 31) * 8;
                if (lat) { bf16_t* dst = (isk ? KL : VL) + ((size_t)b * SKV_LAT + 512 + s) * 256 + off; *(u32x4*)dst = kvw; }
                else { bf16_t* dst = (isk ? KC : VC) + (size_t)tok * 256 + off; *(u32x4*)dst = kvw;
                    float* fo = (isk ? ctxk : ctxv) + (size_t)tok * 256 + off;
                    *(f32x4*)fo = (f32x4){kv[0], kv[1], kv[2], kv[3]}; *(f32x4*)(fo + 4) = (f32x4){kv[4], kv[5], kv[6], kv[7]}; }
            } }
    }
}
__device__ __forceinline__ void add8(float (&acc)[8], const u32x4 w, float wgt) {
    acc[0] += wgt * bf_lo(w.x); acc[1] += wgt * bf_hi(w.x); acc[2] += wgt * bf_lo(w.y); acc[3] += wgt * bf_hi(w.y);
    acc[4] += wgt * bf_lo(w.z); acc[5] += wgt * bf_hi(w.z); acc[6] += wgt * bf_lo(w.w); acc[7] += wgt * bf_hi(w.w);
}
__device__ __forceinline__ void seq_bounds(int t, int& sb, int& se) { if (t < MCTX) { sb = t & ~255; se = sb + 256; } else { sb = MCTX + ((t - MCTX) & ~4095); se = sb + 4096; } }
__device__ __forceinline__ void window_init(const bf16_t* __restrict__ pb, int cur, int half, float (&acc)[8]) {
    int sb, se; seq_bounds(cur, sb, se);
#pragma unroll
    for (int e = 0; e < 8; ++e) acc[e] = 0.f;
    for (int i = 0; i < 2 * half; ++i) { const int r = cur - half + i; const float wgt = (r >= sb && r < se) ? 1.f : 0.f; const int rc = min(max(r, sb), se - 1);
        add8(acc, *(const u32x4*)(pb + (size_t)rc * NIN), wgt); }
}
__device__ void phase_pooled(const Args& a) {
    int tid_l = threadIdx.x; asm volatile("" : "+v"(tid_l));
    const bf16_t* __restrict__ PROJ = (const bf16_t*)(a.ws + WS_PROJ); bf16_t* __restrict__ PO = (bf16_t*)(a.ws + WS_POOLED);
    constexpr int RUN = 20, NITEM = (MTOT / RUN) * 128;
    for (int item = blockIdx.x * 512 + tid_l; item < NITEM; item += gridDim.x * 512) {
        const int run = item >> 7, oct = item & 127, half = 1 << (oct >> 5);
        const int r0 = run * RUN;
        const bf16_t* pb = PROJ + 1536 + 8 * oct;
        bf16_t* ob = PO + 8 * oct;
        float acc[8];
        window_init(pb, r0, half, acc);
#pragma unroll 4
        for (int j = 0; j < RUN; ++j) {
            const int cur = r0 + j;
            int sb, se; seq_bounds(cur, sb, se);
            const int lo = max(cur - half, sb), hi = min(cur + half, se);
            const u32x4 self = *(const u32x4*)(pb + (size_t)cur * NIN);
            const int rin = cur + half, rout = cur - half;
            const u32x4 win = *(const u32x4*)(pb + (size_t)min(rin, se - 1) * NIN), wout = *(const u32x4*)(pb + (size_t)max(rout, sb) * NIN);
            const float ic = 1.0f / (float)(hi - lo);
            float sv[8]; unpack8(self, sv);
            float o[8];
#pragma unroll
            for (int e = 0; e < 8; ++e) o[e] = acc[e] * ic - sv[e];
            *(u32x4*)(ob + (size_t)cur * 1024) = pack8(o);
            if (cur + 1 < se) { add8(acc, win, rin < se ? 1.f : 0.f); add8(acc, wout, rout >= sb ? -1.f : 0.f); }
            else if (j + 1 < RUN) window_init(pb, cur + 1, half, acc);
        }
    }
}

typedef const Args __attribute__((address_space(4)))* KArgsP;
__device__ __forceinline__ Args load_args() {
    Args r;
#if defined(__HIP_DEVICE_COMPILE__)
    KArgsP p = (KArgsP)__builtin_amdgcn_kernarg_segment_ptr(); asm volatile("" : "+s"(p));
#pragma unroll
    for (int i = 0; i < 20; ++i) r.in[i] = p->in[i];
    r.out = p->out; r.ws = p->ws;
#endif
    return r;
}
#define SEAM() do { XcdBarrier xb_; { unsigned* bp_ = (unsigned*)(load_args().ws + WS_BAR); asm volatile("" : "+s"(bp_)); xb_.bar = bp_; } xb_.x = xb_xcc_id(); \
    xb_.st = (volatile LAS unsigned*)((PG8_LAS unsigned char*)shm + 131072); xcd_barrier(xb_); } while (0)
#ifndef REP_P0
#define REP_P0 1
#endif
#ifndef REP_P3B
#define REP_P3B 1
#endif
#ifndef REP_P6
#define REP_P6 1
#endif
__global__ void __launch_bounds__(512, 2) mega_fwd(Args a_unused) {
    extern __shared__ __attribute__((aligned(16))) unsigned char shm[];
    PG8_LAS unsigned char* lds3 = (PG8_LAS unsigned char*)shm;
    const int G = gridDim.x, bid = blockIdx.x;

    { const Args a = load_args();
      unsigned* barw = (unsigned*)(a.ws + WS_BAR);
      volatile LAS unsigned* bst = (volatile LAS unsigned*)(lds3 + 131072);
      if (bid == 0) for (int i = threadIdx.x; i < XCD_BAR_WORDS; i += 512) barw[i] = 0u;
      if (threadIdx.x == 0) { bst[0] = 0u; bst[1] = 0u; }
      for (int rep = 0; rep < REP_P0; ++rep) phase_prep(a, (float*)shm);
      cg::this_grid().sync();
      (void)xcd_barrier_post(barw, bst); }
    { const Args a = load_args(); phase_ln_in(a); }
    SEAM();
    { const Args a = load_args(); unsigned char* ws = a.ws;
      pg8::Gemm g{(const bf16_t*)(ws + WS_ACT), (const bf16_t*)(ws + WS_WIN), MTOT, NIN, DM, DM, DM, 0}; pg8::StaticOrder S; S.init(MTOT, NIN, G, bid);
      EpiB<0, false> E{(bf16_t*)(ws + WS_PROJ), NIN, nullptr};
      pg8::gemm_phase<EpiB<0, false>, pg8::StaticOrder>(lds3, g, S, E, nullptr);
      if (G == 256) slack_transposes(a, T_WIN, T_WIN + T_WOUT + T_FF1 + T_FF2 / 2, 32); }
    SEAM();
    { const Args a = load_args(); phase_elem(a); phase_pooled(a); }
    SEAM();
    for (int rep = 0; rep < REP_P3B; ++rep) {
        const Args a = load_args(); unsigned char* ws = a.ws;
        const att::bf16* Qb = (const att::bf16*)(ws + WS_PROJ); bf16_t* ACT = (bf16_t*)(ws + WS_ACT);
        for (int u = bid; u < 640; u += G) {
            const bool lat = u < 512; const int uu = lat ? u : u - 512;
            const int h = lat ? ((uu >> 4) & 7) : (uu & 7), b = lat ? (uu >> 7) : (uu >> 3);
            const size_t tok0 = lat ? ((size_t)MCTX + (size_t)b * 4096 + (uu & 15) * 256) : (size_t)b * 256;
            const size_t kvoff = (lat ? (size_t)b * SKV_LAT * 256 : tok0 * 256) + (h >> 2) * 128;
            const att::bf16* Kh = (const att::bf16*)(ws + (lat ? WS_KLAT : WS_KCTX)) + kvoff;
            const att::bf16* Vh = (const att::bf16*)(ws + (lat ? WS_VLAT : WS_VCTX)) + kvoff;
            __syncthreads();
            att::attn_dense_body<att::bf16>(Qb + tok0 * NIN + h * 128, Kh, Vh, ACT + tok0 * DM + h * 128, lat ? SKV_LAT : 256, (char*)shm,
                                            a.in[I_QG], (const float*)(ws + WS_ROPE), (const float*)(ws + WS_ROPE) + 2048, lat ? (uu & 15) * 256 : 0, lat);
        }
        __syncthreads();
        pg8::Gemm g{(const bf16_t*)(ws + WS_POOLED), (const bf16_t*)(ws + WS_WPOOL), MTOT, 1024, 256, 1024, 256, 512}; pg8::StaticOrder S; S.init(MTOT, 1024, G, (bid + G / 2) % G);
        EpiB<0, true> E{ACT + 1024, DM, a.in[I_PSCALE]};
        pg8::gemm_phase<EpiB<0, true>, pg8::StaticOrder>(lds3, g, S, E, nullptr);
    }
    SEAM();
    { const Args a = load_args(); unsigned char* ws = a.ws;
      pg8::Gemm g{(const bf16_t*)(ws + WS_ACT), (const bf16_t*)(ws + WS_WOUT), MTOT, DM, DM, DM, DM, 0}; pg8::StaticOrder S; S.init(MTOT, DM, G, bid);
      EpiPre1 E{a.in[I_XP], a.in[I_XS], (bf16_t*)a.out, (const float*)(ws + WS_MOD) + 2 * DM};
      pg8::gemm_phase<EpiPre1, pg8::StaticOrder>(lds3, g, S, E, nullptr);
      if (G == 256) slack_transposes(a, T_WIN + T_WOUT + T_FF1 + T_FF2 / 2, T_WIN + T_WOUT + T_FF1 + T_FF2, 128); }
    SEAM();
    { const Args a = load_args(); phase_ln_mid(a); }
    SEAM();
    for (int rep = 0; rep < REP_P6; ++rep) { const Args a = load_args(); unsigned char* ws = a.ws;
      pg8::Gemm g{(const bf16_t*)(ws + WS_ACT), (const bf16_t*)(ws + WS_WFF1), MTOT, DFF, DM, DM, DM, 0}; pg8::StaticOrder S; S.init(MTOT, DFF, G, bid);
      EpiB<1, false> E{(bf16_t*)(ws + WS_H), DFF, nullptr};
      pg8::gemm_phase<EpiB<1, false>, pg8::StaticOrder>(lds3, g, S, E, nullptr); }
    SEAM();
    { const Args a = load_args(); unsigned char* ws = a.ws;
      pg8::Gemm g{(const bf16_t*)(ws + WS_H), (const bf16_t*)(ws + WS_WFF2), MTOT, DM, DFF, DFF, DFF, 0};
      EpiPre2 E{(const bf16_t*)a.out, (const float*)(ws + WS_STATS), a.in[I_LN1G], a.in[I_LN1B], (bf16_t*)(ws + WS_ACT), (const float*)(ws + WS_MOD) + 5 * DM, (bf16_t*)(ws + WS_PART)};
      if (G == 256) { SplitOrder S; S.c = bid; pg8::gemm_phase<EpiPre2, SplitOrder>(lds3, g, S, E, nullptr); }
      else { pg8::StaticOrder S; S.init(MTOT, DM, G, bid); pg8::gemm_phase<EpiPre2, pg8::StaticOrder>(lds3, g, S, E, nullptr); } }
    SEAM();
    { const Args a = load_args(); phase_ln_out(a, (const bf16_t*)(a.ws + WS_ACT), G == 256 ? (const bf16_t*)(a.ws + WS_PART) : nullptr); }
}

extern "C" void kernel_launch(void* const* d_in, const int* in_sizes, int n_in, void* d_out, int out_size, void* d_ws, size_t ws_size, hipStream_t stream) {
    static int grid = 0;
    if (grid == 0) {
        if (n_in != 20 || ws_size < WS_END) { fprintf(stderr, "kernel_launch: need 20 inputs and %zu bytes of workspace (got %d, %zu)\n", (size_t)WS_END, n_in, ws_size); grid = -1; return; }
        int dev = 0, cus = 0, per_cu = 0;
        hipGetDevice(&dev); hipDeviceGetAttribute(&cus, hipDeviceAttributeMultiprocessorCount, dev);
        if (hipFuncSetAttribute((const void*)mega_fwd, hipFuncAttributeMaxDynamicSharedMemorySize, LDS_BYTES) != hipSuccess) { fprintf(stderr, "kernel_launch: hipFuncSetAttribute failed\n"); grid = -1; return; }
        if (hipOccupancyMaxActiveBlocksPerMultiprocessor(&per_cu, (const void*)mega_fwd, 512, LDS_BYTES) != hipSuccess || per_cu < 1) { fprintf(stderr, "kernel_launch: occupancy query says %d\n", per_cu); per_cu = 1; }
        (void)hipGetLastError();
        grid = cus * 1;
    }
    if (grid < 0) return;
    Args a{};
    for (int i = 0; i < 20; ++i) a.in[i] = (const float*)d_in[i];
    a.out = (float*)d_out; a.ws = (unsigned char*)d_ws;
    void* args[] = {&a};
    hipError_t e = hipLaunchCooperativeKernel((const void*)mega_fwd, dim3(grid), dim3(512), args, LDS_BYTES, stream);
    if (e != hipSuccess) fprintf(stderr, "kernel_launch: cooperative launch failed: %s (grid %d)\n", hipGetErrorString(e), grid);
}
```

```cpp
#include <hip/hip_runtime.h>
#include <hip/hip_bf16.h>
#include <hip/hip_cooperative_groups.h>
#include <cstdio>
#include <cstdint>
namespace cg = cooperative_groups;

constexpr int DM = 2048, MCTX = 4096, MLAT = 16384, MTOT = 20480, NIN = 2560, DFF = 8192, SKV_LAT = 4608, NMOD = 12288;
constexpr float LN_EPS = 1e-6f, ALPHA = 1.189207115002721f;
constexpr size_t al256(size_t x) { return (x + 255) / 256 * 256; }
constexpr size_t WS_WIN = 0;
constexpr size_t WS_WOUT = WS_WIN + (size_t)NIN * DM * 2;
constexpr size_t WS_WFF1 = WS_WOUT + (size_t)DM * DM * 2;
constexpr size_t WS_WFF2 = WS_WFF1 + (size_t)DFF * DM * 2;
constexpr size_t WS_WPOOL = WS_WFF2 + (size_t)DFF * DM * 2;
constexpr size_t WS_MOD = WS_WPOOL + (size_t)1024 * 256 * 2;
constexpr size_t WS_ROPE = WS_MOD + al256((size_t)5 * NMOD * 4);
constexpr size_t WS_BAR = WS_ROPE + 16384;
constexpr size_t WS_ACT = WS_BAR + 16384;
constexpr size_t WS_BIG = WS_ACT + (size_t)MTOT * DM * 2;
constexpr size_t WS_PROJ = WS_BIG;
constexpr size_t WS_Q = WS_PROJ + (size_t)MTOT * NIN * 2;
constexpr size_t WS_KLAT = WS_Q + (size_t)MTOT * 1024 * 2;
constexpr size_t WS_VLAT = WS_KLAT + (size_t)4 * SKV_LAT * 256 * 2;
constexpr size_t WS_KCTX = WS_VLAT + (size_t)4 * SKV_LAT * 256 * 2;
constexpr size_t WS_VCTX = WS_KCTX + (size_t)MCTX * 256 * 2;
constexpr size_t WS_POOLED = WS_VCTX + (size_t)MCTX * 256 * 2;
constexpr size_t WS_BIG_END1 = WS_POOLED + (size_t)MTOT * 1024 * 2;
constexpr size_t WS_H = WS_BIG;
constexpr size_t WS_STATS = WS_H + (size_t)MTOT * DFF * 2;
constexpr size_t WS_PART = WS_STATS + al256((size_t)MTOT * 2 * 4);
constexpr size_t WS_END = WS_PART + (size_t)4096 * DM * 2;
static_assert(WS_BIG_END1 <= WS_END, "aliasing");
constexpr int LDS_BYTES = 131072 + 16;

namespace pg8 {
#define PG8_LAS __attribute__((address_space(3)))
typedef unsigned short bf16_t;
typedef short bf16x8 __attribute__((ext_vector_type(8)));
typedef float f32x4 __attribute__((ext_vector_type(4)));
typedef unsigned u32x4 __attribute__((ext_vector_type(4)));
constexpr int BM = 256, BK = 64, HALF = 128, HTB = HALF * BK * 2  , STAGE_BYTES = 8 * HTB, NXCD = 8, WGM = 8;

__host__ __device__ __forceinline__ int lds_byte(int r, int c) { const int st = (r >> 4) * 2 + (c >> 5), rr = r & 15, cc = c & 31, ob = rr * 64 + cc * 2; return st * 1024 + (ob ^ (((ob >> 9) & 1) << 5)); }
__host__ __device__ __forceinline__ void stage_rc(int b, int& R, int& C) { const int st = b / 1024, sb = b % 1024, swz = sb ^ (((sb >> 9) & 1) << 5); R = (st >> 1) * 16 + swz / 64; C = (st & 1) * 32 + (swz % 64) / 2; }
__host__ __device__ __forceinline__ int perm32(int rho) { const int n = rho >> 4, i = rho & 15; return 8 * (i >> 2) + 4 * n + (i & 3); }

struct Unit { int pm, pn, kt0, nkt, ks; };
struct Gemm { const bf16_t* A; const bf16_t* Bt; int M, N, K, lda, ldb, a_pn_off; };

struct StaticOrder {
    int nM, nN, nwg, G, c;
    __host__ __device__ void init(int M, int N, int G_, int c_) { nM = M / BM; nN = N / BM; nwg = nM * nN; G = G_; c = c_; }
    __host__ __device__ bool next(int i, Unit& u) const {
        const long L = (long)i * G + c; if (L >= nwg) return false;
        int wgid = (int)L; { const int q = nwg / NXCD, r = nwg % NXCD, xcd = wgid % NXCD, off = wgid / NXCD; wgid = (xcd < r ? xcd * (q + 1) : r * (q + 1) + (xcd - r) * q) + off; }
        const int nig = WGM * nN, gid = wgid / nig, fm = gid * WGM, gsz = (nM - fm) < WGM ? (nM - fm) : WGM;
        u.pm = fm + ((wgid % nig) % gsz); u.pn = (wgid % nig) / gsz; return true;
    }
    __device__ __forceinline__ void a_ready(const Unit&) const {}
    __device__ __forceinline__ void done(const Unit&) const {}
};
__device__ __forceinline__ unsigned cvt_pk_bf16(float lo, float hi) { unsigned r; asm volatile("v_cvt_pk_bf16_f32 %0, %1, %2" : "=v"(r) : "v"(lo), "v"(hi)); return r; }
template <class Epi, class Sched, bool STAMP = false>
__device__ __forceinline__ void gemm_phase(PG8_LAS unsigned char* lds, const Gemm g, const Sched& S, const Epi& E, unsigned long long* stamps) {
    int tid_l = threadIdx.x; asm volatile("" : "+v"(tid_l));
    const int tid = tid_l, wid = __builtin_amdgcn_readfirstlane(tid >> 6), lane = tid & 63, wr = wid >> 2, wc = wid & 3, fr = lane & 15, fq = lane >> 4;
    const int K = g.K, nt = K / BK;
    int ts_lo = 0, ts_hi = 0, nts = 0; const unsigned long long rt_entry = STAMP ? (unsigned long long)wall_clock64() : 0ull;
#define PG8_STAMP() do { if (STAMP && wid == 0 && nts < 64) { const unsigned long long _c = (unsigned long long)clock64(); \
        ts_lo = (lane == nts) ? (int)(unsigned)_c : ts_lo; ts_hi = (lane == nts) ? (int)(unsigned)(_c >> 32) : ts_hi; ++nts; } } while (0)
    PG8_STAMP();
    unsigned voffA[2], voffB[2];
#pragma unroll
    for (int i = 0; i < 2; ++i) { int R, C; stage_rc(tid * 16 + i * 8192, R, C); const int Rb = Epi::PERM ? ((R & ~31) + perm32(R & 31)) : R;
        voffA[i] = (unsigned)(R * g.lda + C) * 2u; voffB[i] = (unsigned)(Rb * g.ldb + C) * 2u; }
    const size_t kstep = (size_t)(BK * 2);
    const size_t hstepA = (size_t)HALF * g.lda * 2, hstepB = (size_t)HALF * g.ldb * 2;
    const size_t tstepA = 2 * hstepA, tstepB = 2 * hstepB;
    const unsigned ldsw = (unsigned)wid * 1024u;
    const int aoff = lds_byte(wr * 64 + fr, fq * 8), boff = lds_byte(wc * 32 + fr, fq * 8);
#define PG8_SA(b, h) (((b) * 2 + (h)) * HTB)
#define PG8_SB(b, h) ((4 + (b) * 2 + (h)) * HTB)
#define PG8_STAGE(bufoff, gbase, voff) do { _Pragma("unroll") for (int _i = 0; _i < 2; ++_i) \
        __builtin_amdgcn_global_load_lds((const unsigned*)((const char*)(gbase) + (voff)[_i]), (PG8_LAS unsigned*)(lds + (bufoff) + ldsw + _i * 8192), 16, 0, 0); } while (0)
#define PG8_LDA(dst, b, h) do { _Pragma("unroll") for (int m = 0; m < 4; ++m) _Pragma("unroll") for (int k = 0; k < 2; ++k) dst[m][k] = *(const PG8_LAS bf16x8*)(lds + PG8_SA(b, h) + aoff + m * 2048 + k * 1024); } while (0)
#define PG8_LDB(dst, b, h) do { _Pragma("unroll") for (int n = 0; n < 2; ++n) _Pragma("unroll") for (int k = 0; k < 2; ++k) dst[n][k] = *(const PG8_LAS bf16x8*)(lds + PG8_SB(b, h) + boff + n * 2048 + k * 1024); } while (0)
#define PG8_MMA(ai, bj, At, Bt) do { __builtin_amdgcn_s_setprio(1); _Pragma("unroll") for (int m = 0; m < 4; ++m) _Pragma("unroll") for (int n = 0; n < 2; ++n) _Pragma("unroll") for (int k = 0; k < 2; ++k) \
        acc[ai][bj][m][n] = __builtin_amdgcn_mfma_f32_16x16x32_bf16(Bt[n][k], At[m][k], acc[ai][bj][m][n], 0, 0, 0); __builtin_amdgcn_s_setprio(0); } while (0)
#define PG8_WAIT_V(n) asm volatile("s_waitcnt vmcnt(" #n ")" ::: "memory")
#define PG8_WAIT_L(n) asm volatile("s_waitcnt lgkmcnt(" #n ")" ::: "memory")
#define PG8_BAR __builtin_amdgcn_s_barrier()
#define PG8_SCHED __builtin_amdgcn_sched_barrier(0)
    Unit cur, nxt; int ui = 0; cur.kt0 = 0; cur.nkt = nt; cur.ks = 0;
    if (!S.next(0, cur)) return;
    f32x4 acc[2][2][4][2];
#pragma unroll
    for (int a = 0; a < 2; ++a)
#pragma unroll
        for (int b = 0; b < 2; ++b)
#pragma unroll
            for (int m = 0; m < 4; ++m)
#pragma unroll
                for (int n = 0; n < 2; ++n) acc[a][b][m][n] = (f32x4){0.f, 0.f, 0.f, 0.f};
    bf16x8 At[4][2], B0[2][2], B1[2][2];
    const char* cA = (const char*)g.A + (size_t)cur.pm * tstepA + (size_t)cur.pn * g.a_pn_off + (size_t)cur.kt0 * kstep; const char* cB = (const char*)g.Bt + (size_t)cur.pn * tstepB + (size_t)cur.kt0 * kstep;
    S.a_ready(cur);
    PG8_STAGE(PG8_SB(0, 0), cB, voffB); PG8_STAGE(PG8_SA(0, 0), cA, voffA); PG8_STAGE(PG8_SB(0, 1), cB + hstepB, voffB); PG8_STAGE(PG8_SA(0, 1), cA + hstepA, voffA);
    if (wr == 1) PG8_BAR;
    PG8_WAIT_V(4); PG8_BAR;
    PG8_STAGE(PG8_SB(1, 0), cB + kstep, voffB); PG8_STAGE(PG8_SA(1, 0), cA + kstep, voffA); PG8_STAGE(PG8_SB(1, 1), cB + hstepB + kstep, voffB);
    PG8_WAIT_V(6); PG8_BAR;
    PG8_STAMP();
    for (;;) {
        nxt.kt0 = 0; nxt.nkt = nt; nxt.ks = 0;
        const bool has_next = S.next(ui + 1, nxt);
        const char* nA = has_next ? (const char*)g.A + (size_t)nxt.pm * tstepA + (size_t)nxt.pn * g.a_pn_off + (size_t)nxt.kt0 * kstep : cA; const char* nB = has_next ? (const char*)g.Bt + (size_t)nxt.pn * tstepB + (size_t)nxt.kt0 * kstep : cB;
        const int cnt = cur.nkt;
        for (int t = 0; t < cnt; t += 2) {
            const bool last = (t == cnt - 2);
            const char* a1 = cA + (size_t)(t + 1) * kstep;
            const char* a2 = last ? nA : cA + (size_t)(t + 2) * kstep; const char* b2 = last ? nB : cB + (size_t)(t + 2) * kstep;
            const char* a3 = a2 + kstep; const char* b3 = b2 + kstep;
            if (last && has_next) S.a_ready(nxt);
            PG8_LDB(B0, 0, 0); PG8_SCHED; PG8_LDA(At, 0, 0); PG8_STAGE(PG8_SA(1, 1), a1 + hstepA, voffA);
            PG8_WAIT_L(8); PG8_BAR; PG8_WAIT_L(0); PG8_MMA(0, 0, At, B0); PG8_BAR; PG8_SCHED;
            PG8_LDB(B1, 0, 1); PG8_STAGE(PG8_SB(0, 0), b2, voffB);
            PG8_BAR; PG8_WAIT_L(0); PG8_MMA(0, 1, At, B1); PG8_BAR;
            PG8_LDA(At, 0, 1); PG8_STAGE(PG8_SA(0, 0), a2, voffA);
            PG8_BAR; PG8_WAIT_L(0); PG8_MMA(1, 0, At, B0); PG8_BAR; PG8_SCHED;
            PG8_STAGE(PG8_SB(0, 1), b2 + hstepB, voffB);
            PG8_WAIT_V(6); PG8_BAR; PG8_MMA(1, 1, At, B1); PG8_BAR;
            PG8_LDB(B0, 1, 0); PG8_SCHED; PG8_LDA(At, 1, 0); PG8_STAGE(PG8_SA(0, 1), a2 + hstepA, voffA);
            PG8_WAIT_L(8); PG8_BAR; PG8_WAIT_L(0); PG8_MMA(0, 0, At, B0); PG8_BAR; PG8_SCHED;
            PG8_LDB(B1, 1, 1); PG8_STAGE(PG8_SB(1, 0), b3, voffB);
            PG8_BAR; PG8_WAIT_L(0); PG8_MMA(0, 1, At, B1); PG8_BAR;
            PG8_LDA(At, 1, 1); PG8_STAGE(PG8_SA(1, 0), a3, voffA);
            PG8_BAR; PG8_WAIT_L(0); PG8_MMA(1, 0, At, B0); PG8_BAR; PG8_SCHED;
            PG8_STAGE(PG8_SB(1, 1), b3 + hstepB, voffB);
            PG8_WAIT_V(6); PG8_BAR; PG8_MMA(1, 1, At, B1); PG8_BAR;
        }
        PG8_STAMP();
        if constexpr (!Epi::AFTER_DRAIN) { E(acc, cur, wr, wc, fr, fq); S.done(cur); }
        PG8_STAMP();
        if (!has_next) break;
#pragma unroll
        for (int a = 0; a < 2; ++a)
#pragma unroll
            for (int b = 0; b < 2; ++b)
#pragma unroll
                for (int m = 0; m < 4; ++m)
#pragma unroll
                    for (int n = 0; n < 2; ++n) acc[a][b][m][n] = (f32x4){0.f, 0.f, 0.f, 0.f};
        cur = nxt; cA = nA; cB = nB; ++ui;
    }
    PG8_WAIT_V(0);
    if (wr == 0) PG8_BAR;
    PG8_BAR;
    if constexpr (Epi::AFTER_DRAIN) { E.fused(acc, cur, wr, wc, fr, fq, lds, wid, lane); S.done(cur); }
    PG8_STAMP();
    if (STAMP && wid == 0) { stamps[lane] = lane < nts ? (((unsigned long long)(unsigned)ts_hi << 32) | (unsigned)ts_lo) : 0ull;
        if (lane == 62) stamps[62] = rt_entry; if (lane == 63) stamps[63] = (unsigned long long)wall_clock64(); }
#undef PG8_STAMP
#undef PG8_SA
#undef PG8_SB
#undef PG8_STAGE
#undef PG8_LDA
#undef PG8_LDB
#undef PG8_MMA
#undef PG8_WAIT_V
#undef PG8_WAIT_L
#undef PG8_BAR
#undef PG8_SCHED
}
}
namespace att {
using bf16 = __hip_bfloat16;
constexpr int   D = 128, NW = 8, QBLK = 32, KVBLK = 64;
constexpr float SCALE = 0.088388347648318440f;
constexpr float THR = 8.f;
#ifndef ATT_SDEPTH
#define ATT_SDEPTH 2
#endif
constexpr int SDEPTH = ATT_SDEPTH;
constexpr int LDQ = 2560, LDK = 256, LDO = 2048;
constexpr size_t SHM_V = KVBLK * D * 2, SHM_K = KVBLK * D * 2, SHM_ATTN = 2 * SHM_V + 2 * SHM_K + NW * 64 * 4;
using bf16x8 = __attribute__((ext_vector_type(8))) short;
using s16x4  = __attribute__((ext_vector_type(4))) short;
using f32x16 = __attribute__((ext_vector_type(16))) float;
using f32x8  = __attribute__((ext_vector_type(8))) float;
using u32x4  = __attribute__((ext_vector_type(4))) unsigned;
#define KSWZ(row, colB) ((row) * 256 + ((colB) ^ (((row) & 7) << 4)))
#define SBAR() __builtin_amdgcn_sched_barrier(0)
__device__ __forceinline__ int crow(int r, int hi) { return (r & 3) + 8 * (r >> 2) + 4 * hi; }
__device__ __forceinline__ unsigned cvtpk(float lo, float hi) {
  unsigned r; asm volatile("v_cvt_pk_bf16_f32 %0, %1, %2" : "=v"(r) : "v"(lo), "v"(hi)); return r;
}
template <typename TIn> struct Stage;
template <> struct Stage<bf16>  { using T = bf16x8;
  __device__ static __forceinline__ T ld8(const bf16* p) { return *reinterpret_cast<const bf16x8*>(p); }
  __device__ static __forceinline__ bf16x8 tobf(T x) { return x; } };
template <> struct Stage<float> { using T = f32x8;
  __device__ static __forceinline__ T ld8(const float* p) { return *reinterpret_cast<const f32x8*>(p); }
  __device__ static __forceinline__ bf16x8 tobf(T x) {
    u32x4 w = {cvtpk(x[0], x[1]), cvtpk(x[2], x[3]), cvtpk(x[4], x[5]), cvtpk(x[6], x[7])}; return *reinterpret_cast<bf16x8*>(&w); } };

__device__ __forceinline__ void partialSM(f32x16& p0, f32x16& p1, float& m_reg, float& mn, float& alpha) {
  constexpr float C = SCALE * 1.4426950408889634f;
  float pmax = p0[0]; for (int r = 1; r < 16; ++r) pmax = fmaxf(pmax, p0[r]); for (int r = 0; r < 16; ++r) pmax = fmaxf(pmax, p1[r]);
  { auto rr = __builtin_amdgcn_permlane32_swap(__float_as_uint(pmax), __float_as_uint(pmax), false, false);
    pmax = fmaxf(__uint_as_float(rr[0]), __uint_as_float(rr[1])); }
  if (__builtin_expect(__all(pmax - m_reg <= THR / SCALE), 1)) { mn = m_reg; alpha = 1.f; }
  else { mn = fmaxf(m_reg, pmax); alpha = __builtin_amdgcn_exp2f((m_reg - mn) * C); m_reg = mn; }
  float mnC = -mn * C;
  for (int r = 0; r < 16; ++r) p0[r] = fmaf(p0[r], C, mnC); for (int r = 0; r < 16; ++r) p1[r] = fmaf(p1[r], C, mnC);
  for (int r = 0; r < 16; ++r) p0[r] = __builtin_amdgcn_exp2f(p0[r]);
}
__device__ __forceinline__ void finishSM(f32x16& p0, f32x16& p1, float alpha, float& l_reg, bf16x8& pa0, bf16x8& pa1, bf16x8& pa2, bf16x8& pa3) {
  for (int r = 0; r < 16; ++r) p1[r] = __builtin_amdgcn_exp2f(p1[r]);
  float ps = 0; for (int r = 0; r < 16; ++r) ps += p0[r]; for (int r = 0; r < 16; ++r) ps += p1[r];
  { auto rr = __builtin_amdgcn_permlane32_swap(__float_as_uint(ps), __float_as_uint(ps), false, false);
    ps = __uint_as_float(rr[0]) + __uint_as_float(rr[1]); }
  l_reg = l_reg * alpha + ps;
#define PK4(P, BASE, OUT) do { unsigned a0 = cvtpk(P[BASE + 0], P[BASE + 1]), a1 = cvtpk(P[BASE + 2], P[BASE + 3]);   \
    unsigned b0 = cvtpk(P[BASE + 4], P[BASE + 5]), b1 = cvtpk(P[BASE + 6], P[BASE + 7]);                              \
    auto r0 = __builtin_amdgcn_permlane32_swap(a0, b0, false, false); auto r1 = __builtin_amdgcn_permlane32_swap(a1, b1, false, false); \
    u32x4 w = {r0[0], r1[0], r0[1], r1[1]}; OUT = *reinterpret_cast<bf16x8*>(&w); } while (0)
  PK4(p0, 0, pa0); PK4(p0, 8, pa1); PK4(p1, 0, pa2); PK4(p1, 8, pa3);
#undef PK4
}
__device__ __forceinline__ void qkt(f32x16& p0, f32x16& p1, const bf16* Ks, const bf16x8* qr, int r32, int hi) {
  p0 = f32x16{}; p1 = f32x16{};
  for (int d0 = 0; d0 < 8; ++d0) { int cb = (d0 * 16 + hi * 8) * 2;
    bf16x8 b0 = *reinterpret_cast<const bf16x8*>((const char*)Ks + KSWZ(r32, cb));
    bf16x8 b1 = *reinterpret_cast<const bf16x8*>((const char*)Ks + KSWZ(32 + r32, cb));
    p0 = __builtin_amdgcn_mfma_f32_32x32x16_bf16(b0, qr[d0], p0, 0, 0, 0);
    p1 = __builtin_amdgcn_mfma_f32_32x32x16_bf16(b1, qr[d0], p1, 0, 0, 0); }
}
__device__ __forceinline__ int v_st(int k, int c) { const int kk = (k & ~0xC) | ((k & 4) << 1) | ((k & 8) >> 1); return ((kk >> 3) * 4 + (c >> 5)) * 512 + ((kk & 7) * 32 + (c & 31)) * 2; }
__device__ __forceinline__ int v_rd_base(int lane) { return ((lane & 3) << 3) | (((lane >> 2) & 3) << 6) | (((lane >> 4) & 1) << 5) | (((lane >> 5) & 1) << 8); }
constexpr int v_rd_off(int d0, int ks, int half) { return d0 * 512 + ks * 4096 + half * 2048; }
template <int OFF> __device__ __forceinline__ s16x4 tr_read(int vb) {
  s16x4 r; asm volatile("ds_read_b64_tr_b16 %0, %1 offset:%2" : "=&v"(r) : "v"(vb), "i"(OFF) : "memory"); return r;
}
template <int D0> __device__ __forceinline__ void pv_one(f32x16& od, int vb, bf16x8 pa0, bf16x8 pa1, bf16x8 pa2, bf16x8 pa3) {
  const s16x4 l0 = tr_read<v_rd_off(D0, 0, 0)>(vb), h0 = tr_read<v_rd_off(D0, 0, 1)>(vb), l1 = tr_read<v_rd_off(D0, 1, 0)>(vb), h1 = tr_read<v_rd_off(D0, 1, 1)>(vb);
  const s16x4 l2 = tr_read<v_rd_off(D0, 2, 0)>(vb), h2 = tr_read<v_rd_off(D0, 2, 1)>(vb), l3 = tr_read<v_rd_off(D0, 3, 0)>(vb), h3 = tr_read<v_rd_off(D0, 3, 1)>(vb);
  asm volatile("s_waitcnt lgkmcnt(0)" ::: "memory"); SBAR();
#define PK(L, H) (bf16x8){L[0], L[1], L[2], L[3], H[0], H[1], H[2], H[3]}
  od = __builtin_amdgcn_mfma_f32_32x32x16_bf16(pa0, PK(l0, h0), od, 0, 0, 0);
  od = __builtin_amdgcn_mfma_f32_32x32x16_bf16(pa1, PK(l1, h1), od, 0, 0, 0);
  od = __builtin_amdgcn_mfma_f32_32x32x16_bf16(pa2, PK(l2, h2), od, 0, 0, 0);
  od = __builtin_amdgcn_mfma_f32_32x32x16_bf16(pa3, PK(l3, h3), od, 0, 0, 0);
#undef PK
}
__device__ __forceinline__ void pv_d0(f32x16* o, int vb, bf16x8 pa0, bf16x8 pa1, bf16x8 pa2, bf16x8 pa3) {
  pv_one<0>(o[0], vb, pa0, pa1, pa2, pa3); pv_one<1>(o[1], vb, pa0, pa1, pa2, pa3); pv_one<2>(o[2], vb, pa0, pa1, pa2, pa3); pv_one<3>(o[3], vb, pa0, pa1, pa2, pa3);
}

template <typename TQ>
__device__ __forceinline__ void attn_dense_body(const TQ* __restrict__ Qb, const bf16* __restrict__ Kh, const bf16* __restrict__ Vh,
                                                unsigned short* __restrict__ Ob, int seq, char* lds,
                                                const float* __restrict__ qgain, const float* __restrict__ ropeC, const float* __restrict__ ropeS, int s0, bool lat) {
  using St = Stage<bf16>; using SQ = Stage<TQ>;
  int tid_l = threadIdx.x; asm volatile("" : "+v"(tid_l));
  const int tid = tid_l, wid = tid >> 6, lane = tid & 63, r32 = lane & 31, hi = lane >> 5;
  bf16* V_lds = (bf16*)lds; bf16* K_lds = (bf16*)(lds + 2 * SHM_V);
  float* ws = (float*)(lds + 2 * SHM_V + 2 * SHM_K) + wid * 64; float* li_l = ws; float* al_l = ws + 32;
  float m_reg = -1e30f, l_reg = 0; f32x16 o[4] = {}; bf16x8 qr[8];
  const TQ* Qw = Qb + (long)(wid * QBLK + r32) * LDQ + hi * 8;
#pragma unroll
  for (int d0 = 0; d0 < 8; ++d0) qr[d0] = SQ::tobf(SQ::ld8(Qw + d0 * 16));
  {
    float xq[8][8];
#pragma unroll
    for (int d0 = 0; d0 < 8; ++d0) { const u32x4 w = *reinterpret_cast<const u32x4*>(&qr[d0]);
      xq[d0][0] = __uint_as_float(w.x << 16); xq[d0][1] = __uint_as_float(w.x & 0xffff0000u); xq[d0][2] = __uint_as_float(w.y << 16); xq[d0][3] = __uint_as_float(w.y & 0xffff0000u);
      xq[d0][4] = __uint_as_float(w.z << 16); xq[d0][5] = __uint_as_float(w.z & 0xffff0000u); xq[d0][6] = __uint_as_float(w.w << 16); xq[d0][7] = __uint_as_float(w.w & 0xffff0000u); }
    float ss = 0.f;
#pragma unroll
    for (int d0 = 0; d0 < 8; ++d0)
#pragma unroll
      for (int e = 0; e < 8; ++e) ss += xq[d0][e] * xq[d0][e];
    { auto rr = __builtin_amdgcn_permlane32_swap(__float_as_uint(ss), __float_as_uint(ss), false, false); ss = __uint_as_float(rr[0]) + __uint_as_float(rr[1]); }
    const float rinv = 1.0f / sqrtf(ss * (1.f / 128.f) + 1e-6f);
#pragma unroll
    for (int d0 = 0; d0 < 8; ++d0) { const float* gp = qgain + d0 * 16 + hi * 8;
      const float4 g0 = *reinterpret_cast<const float4*>(gp), g1 = *reinterpret_cast<const float4*>(gp + 4);
      xq[d0][0] *= rinv * g0.x; xq[d0][1] *= rinv * g0.y; xq[d0][2] *= rinv * g0.z; xq[d0][3] *= rinv * g0.w;
      xq[d0][4] *= rinv * g1.x; xq[d0][5] *= rinv * g1.y; xq[d0][6] *= rinv * g1.z; xq[d0][7] *= rinv * g1.w; }
    if (lat) {
      const int spos = s0 + wid * QBLK + r32;
#pragma unroll
      for (int part = 0; part < 2; ++part) { const int pos = part ? (spos & 63) : (spos >> 6);
#pragma unroll
        for (int q2 = 0; q2 < 2; ++q2) { const int a = part * 4 + q2, b = a + 2; const int fi0 = q2 * 16 + hi * 8;
          const float* cp = ropeC + pos * 32 + fi0; const float* sp = ropeS + pos * 32 + fi0;
          const float4 c0 = *reinterpret_cast<const float4*>(cp), c1 = *reinterpret_cast<const float4*>(cp + 4), n0 = *reinterpret_cast<const float4*>(sp), n1 = *reinterpret_cast<const float4*>(sp + 4);
          const float cc[8] = {c0.x, c0.y, c0.z, c0.w, c1.x, c1.y, c1.z, c1.w}, sn[8] = {n0.x, n0.y, n0.z, n0.w, n1.x, n1.y, n1.z, n1.w};
#pragma unroll
          for (int e = 0; e < 8; ++e) { const float x1 = xq[a][e], x2 = xq[b][e]; xq[a][e] = x1 * cc[e] - x2 * sn[e]; xq[b][e] = x2 * cc[e] + x1 * sn[e]; } } }
    }
#pragma unroll
    for (int d0 = 0; d0 < 8; ++d0) { u32x4 w = {cvtpk(xq[d0][0], xq[d0][1]), cvtpk(xq[d0][2], xq[d0][3]), cvtpk(xq[d0][4], xq[d0][5]), cvtpk(xq[d0][6], xq[d0][7])}; qr[d0] = *reinterpret_cast<bf16x8*>(&w); }
  }
  const int sr = tid >> 4, sc = (tid & 15) * 8, vst0 = v_st(sr, sc), vst1 = v_st(32 + sr, sc);
  const int vb0 = (int)(uintptr_t)V_lds + v_rd_base(lane);
  struct { typename St::T vs0, vs1, ks0, ks1; } sr_[SDEPTH];
#define SLOAD(i, k0) do { sr_[i].vs0 = St::ld8(&Vh[(long)((k0) + sr) * LDK + sc]); sr_[i].vs1 = St::ld8(&Vh[(long)((k0) + 32 + sr) * LDK + sc]); \
    sr_[i].ks0 = St::ld8(&Kh[(long)((k0) + sr) * LDK + sc]); sr_[i].ks1 = St::ld8(&Kh[(long)((k0) + 32 + sr) * LDK + sc]); } while (0)
#define SWRITE(b, i) do { *(bf16x8*)((char*)V_lds + (b) * SHM_V + vst0) = St::tobf(sr_[i].vs0);          \
    *(bf16x8*)((char*)V_lds + (b) * SHM_V + vst1) = St::tobf(sr_[i].vs1); int kc = sc * 2;               \
    *(bf16x8*)((char*)K_lds + (b) * SHM_K + KSWZ(sr, kc)) = St::tobf(sr_[i].ks0);                       \
    *(bf16x8*)((char*)K_lds + (b) * SHM_K + KSWZ(32 + sr, kc)) = St::tobf(sr_[i].ks1); } while (0)
#define SWAIT() do { if constexpr (SDEPTH == 2) asm volatile("s_waitcnt vmcnt(4)" ::: "memory"); else asm volatile("s_waitcnt vmcnt(0)" ::: "memory"); } while (0)
#define RESC(a) do { if (__any((a) < 1.f)) { if (hi == 0) al_l[r32] = (a); asm volatile("s_waitcnt lgkmcnt(0)" ::: "memory"); \
    for (int d = 0; d < 4; ++d) for (int r = 0; r < 16; ++r) o[d][r] *= al_l[crow(r, hi)]; } } while (0)
  f32x16 pA0, pA1, pB0, pB1; float mnA, mnB, alA, alB; bf16x8 pa0, pa1, pa2, pa3; const int NT = seq / KVBLK;
  constexpr int SE = 0, SO = SDEPTH - 1;
  SLOAD(SE, 0); asm volatile("s_waitcnt vmcnt(0)" ::: "memory"); SWRITE(0, SE); __syncthreads();
  qkt(pA0, pA1, K_lds, qr, r32, hi); partialSM(pA0, pA1, m_reg, mnA, alA);
  SLOAD(SO, KVBLK); if constexpr (SDEPTH == 2) { if (2 < NT) SLOAD(SE, 2 * KVBLK); }
  SWAIT(); SWRITE(1, SO); __syncthreads();
  for (int j = 1; j + 1 < NT; j += 2) {
    SBAR(); qkt(pB0, pB1, (bf16*)((char*)K_lds + SHM_K), qr, r32, hi);
    finishSM(pA0, pA1, alA, l_reg, pa0, pa1, pa2, pa3); SBAR();
    SLOAD(SO, (j + SDEPTH) * KVBLK); SBAR();
    pv_d0(o, vb0, pa0, pa1, pa2, pa3); partialSM(pB0, pB1, m_reg, mnB, alB);
    __syncthreads(); SWAIT(); SWRITE(0, SE);
    RESC(alB); __syncthreads();
    SBAR(); qkt(pA0, pA1, K_lds, qr, r32, hi);
    finishSM(pB0, pB1, alB, l_reg, pa0, pa1, pa2, pa3); SBAR();
    if (SDEPTH == 1 || j + 3 < NT) SLOAD(SE, (j + 1 + SDEPTH) * KVBLK); SBAR();
    pv_d0(o, vb0 + (int)SHM_V, pa0, pa1, pa2, pa3); partialSM(pA0, pA1, m_reg, mnA, alA);
    __syncthreads(); SWAIT(); SWRITE(1, SO);
    RESC(alA); __syncthreads();
  }
  SBAR(); qkt(pB0, pB1, (bf16*)((char*)K_lds + SHM_K), qr, r32, hi);
  finishSM(pA0, pA1, alA, l_reg, pa0, pa1, pa2, pa3); SBAR();
  pv_d0(o, vb0, pa0, pa1, pa2, pa3); partialSM(pB0, pB1, m_reg, mnB, alB);
  __syncthreads(); RESC(alB);
  finishSM(pB0, pB1, alB, l_reg, pa0, pa1, pa2, pa3); SBAR();
  pv_d0(o, vb0 + (int)SHM_V, pa0, pa1, pa2, pa3);
  if (hi == 0) li_l[r32] = l_reg; asm volatile("s_waitcnt lgkmcnt(0)" ::: "memory");
  float rli[16];
#pragma unroll
  for (int r = 0; r < 16; ++r) rli[r] = __builtin_amdgcn_rcpf(li_l[crow(r, hi)]);
  unsigned short* Ow = Ob + (long)(wid * QBLK) * LDO;
#pragma unroll
  for (int r = 0; r < 16; ++r) { int orow = crow(r, hi);
    for (int d0 = 0; d0 < 4; ++d0) Ow[(long)orow * LDO + d0 * 32 + r32] = (unsigned short)(cvtpk(o[d0][r] * rli[r], 0.f) & 0xffffu); }
#undef SLOAD
#undef SWRITE
#undef SWAIT
#undef RESC
}
}
#define XB_TMO      128
#define XB_XCNT(j)  (256  + 64 * (j))
#define XB_XSUB(j)  (1280 + 64 * (j))
#define XB_XGEN(j)  (2304 + 64 * (j))
#define XB_TOP      3328
#define XB_TOPGEN   3392
#define XCD_BAR_WORDS 3456
#define XB_SPIN_CAP (1u << 18)
#define LAS __attribute__((address_space(3)))

__device__ __forceinline__ unsigned xb_ld(unsigned* p)              { return __hip_atomic_load(p, __ATOMIC_RELAXED, __HIP_MEMORY_SCOPE_AGENT); }
__device__ __forceinline__ unsigned xb_add(unsigned* p, unsigned v) { return __hip_atomic_fetch_add(p, v, __ATOMIC_RELAXED, __HIP_MEMORY_SCOPE_AGENT); }
__device__ __forceinline__ unsigned xb_xcc_id() { return (unsigned)__builtin_amdgcn_s_getreg((3 << 11) | 20) & 0xFu; }
#define XB_SPIN(cond, bar) do { unsigned _sp = 0; while (cond) { __builtin_amdgcn_s_sleep(1); \
    if ((++_sp & 255u) == 0u) { if (xb_ld(&(bar)[XB_TMO])) break; if (_sp > XB_SPIN_CAP) { atomicAdd(&(bar)[XB_TMO], 1u); break; } } } } while (0)

struct XcdBarrier {
    unsigned* bar; unsigned x;
    volatile LAS unsigned* st;
};

__device__ __forceinline__ XcdBarrier xcd_barrier_post(unsigned* bar, volatile LAS unsigned* st) {
    XcdBarrier b; b.bar = bar; b.x = xb_xcc_id(); b.st = st;
    if (threadIdx.x == 0) (void)xb_add(&bar[XB_XCNT(b.x)], 1u);
    return b;
}
__device__ __forceinline__ void xcd_barrier_complete(unsigned* bar, unsigned x, unsigned& nloc, unsigned& nx) {
    const unsigned G = gridDim.x * gridDim.y * gridDim.z;
    unsigned sum, cnt, mine, sp = 0u;
    for (;;) {
        sum = 0u; cnt = 0u; mine = 0u;
#pragma unroll
        for (unsigned j = 0; j < 16; ++j) { const unsigned c = xb_ld(&bar[XB_XCNT(j)]); sum += c; cnt += (c > 0u) ? 1u : 0u; mine = (j == x) ? c : mine; }
        if (sum == G) break;
        __builtin_amdgcn_s_sleep(1);
        if ((++sp & 255u) == 0u) { if (xb_ld(&bar[XB_TMO])) break; if (sp > XB_SPIN_CAP) { atomicAdd(&bar[XB_TMO], 1u); break; } }
    }
    nloc = mine > 0u ? mine : 1u; nx = cnt > 0u ? cnt : 1u;
}

__device__ __forceinline__ void xcd_barrier(const XcdBarrier& b) {
    asm volatile("s_waitcnt vmcnt(0)" ::: "memory");
    __syncthreads();
    if (threadIdx.x == 0) {
        unsigned* bar = b.bar;
        __builtin_amdgcn_s_waitcnt(0);
        unsigned nloc = b.st[0], nx = b.st[1];
        if (nloc == 0u) { xcd_barrier_complete(bar, b.x, nloc, nx); b.st[0] = nloc; b.st[1] = nx; }
        const unsigned old = xb_add(&bar[XB_XSUB(b.x)], 1u);
        const unsigned gen = old / nloc;
        if (old + 1u == (gen + 1u) * nloc) {
            __builtin_amdgcn_fence(__ATOMIC_RELEASE, "agent");
            asm volatile("s_waitcnt vmcnt(0)" ::: "memory");
            const unsigned og = xb_add(&bar[XB_TOP], 1u);
            const unsigned tg = og / nx;
            if (og + 1u == (tg + 1u) * nx) xb_add(&bar[XB_TOPGEN], 1u);
            else XB_SPIN(xb_ld(&bar[XB_TOPGEN]) == tg, bar);
            __builtin_amdgcn_fence(__ATOMIC_ACQUIRE, "agent");
            xb_add(&bar[XB_XGEN(b.x)], 1u);
            asm volatile("s_waitcnt vmcnt(0)" ::: "memory");
        } else {
            XB_SPIN(xb_ld(&bar[XB_XGEN(b.x)]) == gen, bar);
            __builtin_amdgcn_fence(__ATOMIC_ACQUIRE, "agent");
            asm volatile("s_waitcnt vmcnt(0)" ::: "memory");
        }
    }
    __syncthreads();
}


using pg8::bf16_t; using pg8::f32x4; using pg8::u32x4; using pg8::Unit; using pg8::cvt_pk_bf16;
typedef unsigned u32x2 __attribute__((ext_vector_type(2)));
struct Args { const float* in[20]; float* out; unsigned char* ws; };
enum { I_XP = 0, I_XS, I_CK, I_CV, I_C, I_CCTX, I_WMOD, I_BMOD, I_WIN, I_QG, I_KG, I_WPOOL, I_PSCALE, I_WOUT, I_LN1G, I_LN1B, I_WFF1, I_WFF2, I_LN2G, I_LN2B };

template <int CTRL> __device__ __forceinline__ float dpp_f(float v) { return __int_as_float(__builtin_amdgcn_update_dpp(0, __float_as_int(v), CTRL, 0xF, 0xF, true)); }
__device__ __forceinline__ float wave_sum(float v) {
    v += dpp_f<0xB1>(v); v += dpp_f<0x4E>(v); v += dpp_f<0x141>(v); v += dpp_f<0x140>(v);
    { auto r = __builtin_amdgcn_permlane16_swap(__float_as_uint(v), __float_as_uint(v), false, false); v = __uint_as_float(r[0]) + __uint_as_float(r[1]); }
    { auto r = __builtin_amdgcn_permlane32_swap(__float_as_uint(v), __float_as_uint(v), false, false); v = __uint_as_float(r[0]) + __uint_as_float(r[1]); }
    return v;
}
__device__ __forceinline__ float bf_lo(unsigned w) { return __uint_as_float(w << 16); }
__device__ __forceinline__ float bf_hi(unsigned w) { return __uint_as_float(w & 0xffff0000u); }
__device__ __forceinline__ int mod_row_of(int row) { return row < MCTX ? 4 : ((row - MCTX) >> 12); }
__device__ __forceinline__ const float* x_row(const Args& a, int row) { return row < MCTX ? a.in[I_XP] + (size_t)row * DM : a.in[I_XS] + (size_t)(row - MCTX) * DM; }

template <int ACT  , bool CS  > struct EpiB {
    static constexpr bool PERM = true, AFTER_DRAIN = false;
    bf16_t* O; int ldc; const float* cs;
    __device__ __forceinline__ void operator()(const f32x4 (&acc)[2][2][4][2], const Unit& u, int wr, int wc, int fr, int fq) const {
        const int row0 = u.pm * 256 + wr * 64 + fr, col0 = u.pn * 256 + wc * 32 + 8 * fq;
#pragma unroll
        for (int bj = 0; bj < 2; ++bj) {
            f32x4 sv0 = {1.f, 1.f, 1.f, 1.f}, sv1 = sv0;
            if (CS) { sv0 = *(const f32x4*)(cs + col0 + bj * 128); sv1 = *(const f32x4*)(cs + col0 + bj * 128 + 4); }
#pragma unroll
            for (int ai = 0; ai < 2; ++ai)
#pragma unroll
                for (int m = 0; m < 4; ++m) { bf16_t* rowp = O + (size_t)(row0 + ai * 128 + m * 16) * ldc + col0 + bj * 128;
                    f32x4 v0 = acc[ai][bj][m][0], v1 = acc[ai][bj][m][1];
                    if (ACT == 1) {
#pragma unroll
                        for (int j = 0; j < 4; ++j) { const float r0 = fmaxf(v0[j], 0.f), r1 = fmaxf(v1[j], 0.f); v0[j] = r0 * r0; v1[j] = r1 * r1; } }
                    if (CS) { v0 = v0 * sv0; v1 = v1 * sv1; }
                    u32x4 w; w.x = cvt_pk_bf16(v0[0], v0[1]); w.y = cvt_pk_bf16(v0[2], v0[3]); w.z = cvt_pk_bf16(v1[0], v1[1]); w.w = cvt_pk_bf16(v1[2], v1[3]);
                    *(u32x4*)rowp = w; }
            asm volatile("" ::: "memory");
        }
    }
};
struct EpiPre1 {
    static constexpr bool PERM = true, AFTER_DRAIN = false;
    const float* __restrict__ xp; const float* __restrict__ xs; bf16_t* __restrict__ pre; const float* __restrict__ gate;
    __device__ __forceinline__ void operator()(const f32x4 (&acc)[2][2][4][2], const Unit& u, int wr, int wc, int fr, int fq) const {
        const int row0 = u.pm * 256 + wr * 64 + fr, col0 = u.pn * 256 + wc * 32 + 8 * fq;
        const int mrow = u.pm < 16 ? 4 : ((u.pm - 16) >> 4);
        const float* gp = gate + (size_t)mrow * NMOD + col0;
        f32x4 gv[2][2];
#pragma unroll
        for (int bj = 0; bj < 2; ++bj)
#pragma unroll
            for (int n = 0; n < 2; ++n) gv[bj][n] = *(const f32x4*)(gp + bj * 128 + n * 4);
#pragma unroll
        for (int ai = 0; ai < 2; ++ai) {
            f32x4 xv[4][2][2];
#pragma unroll
            for (int m = 0; m < 4; ++m) { const int row = row0 + ai * 128 + m * 16;
                const float* xr = (row < MCTX ? xp + (size_t)row * DM : xs + (size_t)(row - MCTX) * DM) + col0;
#pragma unroll
                for (int bj = 0; bj < 2; ++bj)
#pragma unroll
                    for (int n = 0; n < 2; ++n) xv[m][bj][n] = *(const f32x4*)(xr + bj * 128 + n * 4); }
#pragma unroll
            for (int m = 0; m < 4; ++m) { bf16_t* prow = pre + (size_t)(row0 + ai * 128 + m * 16) * DM + col0;
#pragma unroll
                for (int bj = 0; bj < 2; ++bj) { const f32x4 v0 = xv[m][bj][0] * ALPHA + gv[bj][0] * acc[ai][bj][m][0], v1 = xv[m][bj][1] * ALPHA + gv[bj][1] * acc[ai][bj][m][1];
                    u32x4 w; w.x = cvt_pk_bf16(v0[0], v0[1]); w.y = cvt_pk_bf16(v0[2], v0[3]); w.z = cvt_pk_bf16(v1[0], v1[1]); w.w = cvt_pk_bf16(v1[2], v1[3]);
                    *(u32x4*)(prow + bj * 128) = w; } }
            asm volatile("" ::: "memory");
        }
    }
};
struct EpiPre2 {
    static constexpr bool PERM = true, AFTER_DRAIN = false;
    const bf16_t* __restrict__ pre1; const float* __restrict__ stats; const float* __restrict__ g1; const float* __restrict__ b1; bf16_t* __restrict__ pre2; const float* __restrict__ gate; bf16_t* __restrict__ part;
    __device__ __forceinline__ void operator()(const f32x4 (&acc)[2][2][4][2], const Unit& u, int wr, int wc, int fr, int fq) const {
        int pn_l = u.pn; asm volatile("" : "+s"(pn_l));
        const int row0 = u.pm * 256 + wr * 64 + fr, col0 = pn_l * 256 + wc * 32 + 8 * fq;
        const int mrow = u.pm < 16 ? 4 : ((u.pm - 16) >> 4);
        const float* gp = gate + (size_t)mrow * NMOD + col0;
        f32x4 gv[2][2];
#pragma unroll
        for (int bj = 0; bj < 2; ++bj)
#pragma unroll
            for (int n = 0; n < 2; ++n) gv[bj][n] = *(const f32x4*)(gp + bj * 128 + n * 4);
        if (u.ks) {
#pragma unroll
            for (int ai = 0; ai < 2; ++ai)
#pragma unroll
                for (int m = 0; m < 4; ++m) { bf16_t* prow = part + (size_t)(row0 + ai * 128 + m * 16 - 16384) * DM + col0;
#pragma unroll
                    for (int bj = 0; bj < 2; ++bj) { const f32x4 v0 = gv[bj][0] * acc[ai][bj][m][0], v1 = gv[bj][1] * acc[ai][bj][m][1];
                        u32x4 w; w.x = cvt_pk_bf16(v0[0], v0[1]); w.y = cvt_pk_bf16(v0[2], v0[3]); w.z = cvt_pk_bf16(v1[0], v1[1]); w.w = cvt_pk_bf16(v1[2], v1[3]);
                        *(u32x4*)(prow + bj * 128) = w; } }
            return;
        }
        f32x4 lg[2][2], lb[2][2];
#pragma unroll
        for (int bj = 0; bj < 2; ++bj)
#pragma unroll
            for (int n = 0; n < 2; ++n) { lg[bj][n] = *(const f32x4*)(g1 + col0 + bj * 128 + n * 4); lb[bj][n] = *(const f32x4*)(b1 + col0 + bj * 128 + n * 4); }
#pragma unroll
        for (int ai = 0; ai < 2; ++ai) {
            u32x4 pv[4][2]; float2 st[4];
#pragma unroll
            for (int m = 0; m < 4; ++m) { const int row = row0 + ai * 128 + m * 16;
                st[m] = *(const float2*)(stats + (size_t)row * 2);
#pragma unroll
                for (int bj = 0; bj < 2; ++bj) pv[m][bj] = *(const u32x4*)(pre1 + (size_t)row * DM + col0 + bj * 128); }
#pragma unroll
            for (int m = 0; m < 4; ++m) { bf16_t* orow = pre2 + (size_t)(row0 + ai * 128 + m * 16) * DM + col0;
                const float mu = st[m].x, rs = st[m].y;
#pragma unroll
                for (int bj = 0; bj < 2; ++bj) { const u32x4 p = pv[m][bj];
                    const f32x4 p0 = {bf_lo(p.x), bf_hi(p.x), bf_lo(p.y), bf_hi(p.y)}, p1 = {bf_lo(p.z), bf_hi(p.z), bf_lo(p.w), bf_hi(p.w)};
                    const f32x4 x0 = (p0 - mu) * rs * lg[bj][0] + lb[bj][0], x1 = (p1 - mu) * rs * lg[bj][1] + lb[bj][1];
                    const f32x4 v0 = x0 * ALPHA + gv[bj][0] * acc[ai][bj][m][0], v1 = x1 * ALPHA + gv[bj][1] * acc[ai][bj][m][1];
                    u32x4 w; w.x = cvt_pk_bf16(v0[0], v0[1]); w.y = cvt_pk_bf16(v0[2], v0[3]); w.z = cvt_pk_bf16(v1[0], v1[1]); w.w = cvt_pk_bf16(v1[2], v1[3]);
                    *(u32x4*)(orow + bj * 128) = w; } }
            asm volatile("" ::: "memory");
        }
    }
};
struct SplitOrder {
    int c;
    __device__ __forceinline__ bool next(int i, Unit& u) const {
        const int xcd = c & 7, offc = c >> 3;
        const bool rem = (i == 2);
        const int pmv = 4 * xcd + (offc & 3);
        const int ks = pmv >> 4;
        u.pm = rem ? 64 + (pmv & 15) : 8 * xcd + 4 * i + (offc & 3);
        u.pn = offc >> 2;
        u.ks = rem ? ks : 0; u.kt0 = rem ? ks * (DFF / 128) : 0; u.nkt = rem ? (DFF / 128) : (DFF / 64);
        return i <= 2;
    }
    __device__ __forceinline__ void a_ready(const Unit&) const {}
    __device__ __forceinline__ void done(const Unit&) const {}
};

__device__ __forceinline__ void transpose_piece(const float* __restrict__ W, int Krows, int Ncols, bf16_t* __restrict__ WT, int kt, int nt, int lane) {
    const int nq = lane >> 3, kg = lane & 7;
    const float* src = W + (size_t)(kt * 64 + kg * 8) * Ncols + nt * 32 + nq * 4;
    f32x4 r[8];
#pragma unroll
    for (int i = 0; i < 8; ++i) r[i] = __builtin_nontemporal_load((const f32x4*)(src + (size_t)i * Ncols));
    bf16_t* dst = WT + (size_t)(nt * 32 + nq * 4) * Krows + kt * 64 + kg * 8;
#pragma unroll
    for (int j = 0; j < 4; ++j) { u32x4 w; w.x = cvt_pk_bf16(r[0][j], r[1][j]); w.y = cvt_pk_bf16(r[2][j], r[3][j]); w.z = cvt_pk_bf16(r[4][j], r[5][j]); w.w = cvt_pk_bf16(r[6][j], r[7][j]);
        *(u32x4*)(dst + (size_t)j * Krows) = w; }
}
constexpr int T_WIN = 32 * 80, T_WOUT = 32 * 64, T_FF1 = 32 * 256, T_FF2 = 128 * 64;
__device__ __forceinline__ void transpose_item(const Args& a, int it, int lane) {
    unsigned char* ws = a.ws;
    if (it < T_WIN) { transpose_piece(a.in[I_WIN], DM, NIN, (bf16_t*)(ws + WS_WIN), it / 80, it % 80, lane); return; }
    it -= T_WIN;
    if (it < T_WOUT) { transpose_piece(a.in[I_WOUT], DM, DM, (bf16_t*)(ws + WS_WOUT), it / 64, it % 64, lane); return; }
    it -= T_WOUT;
    if (it < T_FF1) { transpose_piece(a.in[I_WFF1], DM, DFF, (bf16_t*)(ws + WS_WFF1), it / 256, it % 256, lane); return; }
    it -= T_FF1;
    if (it < T_FF2) { transpose_piece(a.in[I_WFF2], DFF, DM, (bf16_t*)(ws + WS_WFF2), it / 64, it % 64, lane); return; }
    it -= T_FF2;
    { const int g = it >> 5, tt = it & 31; transpose_piece(a.in[I_WPOOL] + (size_t)g * 65536, 256, 256, (bf16_t*)(ws + WS_WPOOL) + (size_t)g * 65536, tt >> 3, tt & 7, lane); }
}
constexpr int N_TITEMS = 32 * 80 + 32 * 64 + 32 * 256 + 128 * 64 + 128;
__device__ __forceinline__ void mod_job(const Args& a, int job, float* __restrict__ mod, float* lds) {
    float* sil = lds; float* red = lds + 5 * DM;
    const int t = threadIdx.x;
    for (int i = t; i < 5 * DM; i += 512) { const float x = (i < 4 * DM) ? a.in[I_C][i] : a.in[I_CCTX][i - 4 * DM]; sil[i] = x / (1.f + __expf(-x)); }
    __syncthreads();
    const int cg4 = t & 15, ch = t >> 4, col0 = job * 64 + cg4 * 4;
    f32x4 a0 = {0.f, 0.f, 0.f, 0.f}, a1 = a0, a2 = a0, a3 = a0, a4 = a0;
    const float* wp = a.in[I_WMOD] + (size_t)(ch * 64) * NMOD + col0;
#pragma unroll 16
    for (int i = 0; i < 64; ++i) { const f32x4 w = __builtin_nontemporal_load((const f32x4*)(wp + (size_t)i * NMOD)); const int d = ch * 64 + i;
        a0 += w * sil[d]; a1 += w * sil[DM + d]; a2 += w * sil[2 * DM + d]; a3 += w * sil[3 * DM + d]; a4 += w * sil[4 * DM + d]; }
    *(f32x4*)(red + (ch * 5 + 0) * 64 + cg4 * 4) = a0; *(f32x4*)(red + (ch * 5 + 1) * 64 + cg4 * 4) = a1; *(f32x4*)(red + (ch * 5 + 2) * 64 + cg4 * 4) = a2;
    *(f32x4*)(red + (ch * 5 + 3) * 64 + cg4 * 4) = a3; *(f32x4*)(red + (ch * 5 + 4) * 64 + cg4 * 4) = a4;
    __syncthreads();
    if (t < 320) { const int r = t >> 6, col = t & 63; float s = 0.f;
#pragma unroll 8
        for (int c = 0; c < 32; ++c) s += red[(c * 5 + r) * 64 + col];
        mod[(size_t)r * NMOD + job * 64 + col] = s + a.in[I_BMOD][job * 64 + col]; }
    __syncthreads();
}
__device__ __forceinline__ void slack_transposes(const Args& a, int lo, int hi, int first_wg) {
    int tid_l = threadIdx.x; asm volatile("" : "+v"(tid_l));
    const int lane = tid_l & 63, wid = tid_l >> 6, bid = blockIdx.x;
    if (bid < first_wg) return;
    for (int it = lo + (bid - first_wg) * 8 + wid; it < hi; it += (256 - first_wg) * 8) transpose_item(a, it, lane);
}
__device__ void phase_prep(const Args& a, float* lds) {
    unsigned char* ws = a.ws;
    float* mod = (float*)(ws + WS_MOD);
    int tid_l = threadIdx.x; asm volatile("" : "+v"(tid_l));
    const int lane = tid_l & 63, wid = tid_l >> 6, G = gridDim.x, bid = blockIdx.x;
    constexpr int J_MOD = NMOD / 64;
    if (G == 256) {
        if (bid < J_MOD) mod_job(a, bid, mod, lds);
        else { for (int it = (bid - J_MOD) * 8 + wid; it < T_WIN; it += 64 * 8) transpose_item(a, it, lane);
               for (int it = N_TITEMS - 128 + (bid - J_MOD) * 8 + wid; it < N_TITEMS; it += 64 * 8) transpose_item(a, it, lane); }
    } else {
        for (int job = bid; job < J_MOD; job += G) mod_job(a, job, mod, lds);
        for (int it = bid * 8 + wid; it < N_TITEMS; it += G * 8) transpose_item(a, it, lane);
    }
    bf16_t* klat = (bf16_t*)(ws + WS_KLAT); bf16_t* vlat = (bf16_t*)(ws + WS_VLAT);
    constexpr int NC8 = 4 * 512 * 256 / 8;
    for (int i = bid * 512 + tid_l; i < 2 * NC8; i += G * 512) {
        const bool isk = i < NC8; const int e = (isk ? i : i - NC8) * 8;
        const float* src = (isk ? a.in[I_CK] : a.in[I_CV]) + e;
        const f32x4 v0 = *(const f32x4*)src, v1 = *(const f32x4*)(src + 4);
        const int b = e / (512 * 256), rem = e % (512 * 256);
        bf16_t* dst = (isk ? klat : vlat) + (size_t)b * SKV_LAT * 256 + rem;
        u32x4 w; w.x = cvt_pk_bf16(v0[0], v0[1]); w.y = cvt_pk_bf16(v0[2], v0[3]); w.z = cvt_pk_bf16(v1[0], v1[1]); w.w = cvt_pk_bf16(v1[2], v1[3]);
        *(u32x4*)dst = w;
    }
    float* ropeC = (float*)(ws + WS_ROPE); float* ropeS = ropeC + 2048;
    for (int i = bid * 512 + tid_l; i < 2048; i += G * 512) { const int pos = i >> 5, fi = i & 31;
        const float inv = exp2f(-(float)fi * (13.287712379549449f / 32.f)); const float ang = (float)pos * inv;
        ropeC[i] = cosf(ang); ropeS[i] = sinf(ang); }
}

__device__ __forceinline__ void row_stats(const f32x4 (&v)[8], float& mu, float& rstd) {
    float s = 0.f;
#pragma unroll
    for (int i = 0; i < 8; ++i) s += (v[i][0] + v[i][1]) + (v[i][2] + v[i][3]);
    s = wave_sum(s); mu = s * (1.f / DM);
    float q = 0.f;
#pragma unroll
    for (int i = 0; i < 8; ++i) { const f32x4 d = v[i] - mu; q += (d[0] * d[0] + d[1] * d[1]) + (d[2] * d[2] + d[3] * d[3]); }
    q = wave_sum(q); rstd = 1.0f / sqrtf(q * (1.f / DM) + LN_EPS);
}
#define LD8(dst, p) do { _Pragma("unroll") for (int _i = 0; _i < 8; ++_i) dst[_i] = *(const f32x4*)((p) + _i * 256 + lane * 4); } while (0)
__device__ __forceinline__ void ln_in_row(const f32x4 (&v)[8], const f32x4 (&sh)[8], const f32x4 (&sc)[8], bf16_t* __restrict__ urow, int lane) {
    float mu, rstd; row_stats(v, mu, rstd);
#pragma unroll
    for (int i = 0; i < 8; ++i) { const int col = i * 256 + lane * 4;
        const f32x4 o = (v[i] - mu) * rstd * (sc[i] + 1.0f) + sh[i];
        u32x2 w; w.x = cvt_pk_bf16(o[0], o[1]); w.y = cvt_pk_bf16(o[2], o[3]);
        *(u32x2*)(urow + col) = w; }
}
__device__ void phase_ln_in(const Args& a) {
    int tid_l = threadIdx.x; asm volatile("" : "+v"(tid_l));
    const int lane = tid_l & 63, wid = tid_l >> 6;
    const float* __restrict__ mod = (const float*)(a.ws + WS_MOD); bf16_t* __restrict__ U = (bf16_t*)(a.ws + WS_ACT);
    const int stride = gridDim.x * 8; int row = blockIdx.x * 8 + wid;
    f32x4 nx0[8], nx1[8];
    if (row < MTOT) { LD8(nx0, x_row(a, row)); LD8(nx1, x_row(a, min(row + stride, MTOT - 1))); }
    for (; row < MTOT; row += 2 * stride) {
        const int row1 = row + stride;
        f32x4 v0[8], v1[8], sh[8], sc[8];
        const int mr0 = mod_row_of(row);
        { const float* mp = mod + (size_t)mr0 * NMOD; LD8(sh, mp); LD8(sc, mp + DM); }
#pragma unroll
        for (int i = 0; i < 8; ++i) { v0[i] = nx0[i]; v1[i] = nx1[i]; }
        LD8(nx0, x_row(a, min(row + 2 * stride, MTOT - 1))); LD8(nx1, x_row(a, min(row + 3 * stride, MTOT - 1)));
        ln_in_row(v0, sh, sc, U + (size_t)row * DM, lane);
        if (row1 < MTOT) {
            const int mr1 = mod_row_of(row1);
            if (mr1 != mr0) { const float* mp = mod + (size_t)mr1 * NMOD; LD8(sh, mp); LD8(sc, mp + DM); }
            ln_in_row(v1, sh, sc, U + (size_t)row1 * DM, lane);
        }
    }
}
__device__ __forceinline__ void ld_row_bf16(const bf16_t* __restrict__ p, int lane, u32x4 (&w)[4]) {
#pragma unroll
    for (int i = 0; i < 4; ++i) w[i] = *(const u32x4*)(p + i * 512 + lane * 8);
}
__device__ __forceinline__ void unpack_row(const u32x4 (&w)[4], float (&v)[32]) {
#pragma unroll
    for (int i = 0; i < 4; ++i) { v[8 * i + 0] = bf_lo(w[i].x); v[8 * i + 1] = bf_hi(w[i].x); v[8 * i + 2] = bf_lo(w[i].y); v[8 * i + 3] = bf_hi(w[i].y);
        v[8 * i + 4] = bf_lo(w[i].z); v[8 * i + 5] = bf_hi(w[i].z); v[8 * i + 6] = bf_lo(w[i].w); v[8 * i + 7] = bf_hi(w[i].w); }
}
__device__ __forceinline__ void ld_vec32(const float* __restrict__ p, int lane, float (&g)[32]) {
#pragma unroll
    for (int i = 0; i < 4; ++i) { const f32x4 a = *(const f32x4*)(p + i * 512 + lane * 8), b = *(const f32x4*)(p + i * 512 + lane * 8 + 4);
#pragma unroll
        for (int e = 0; e < 4; ++e) { g[8 * i + e] = a[e]; g[8 * i + 4 + e] = b[e]; } }
}
__device__ __forceinline__ void stats32(const float (&v)[32], float& mu, float& rstd) {
    float s = 0.f;
#pragma unroll
    for (int i = 0; i < 32; ++i) s += v[i];
    s = wave_sum(s); mu = s * (1.f / DM);
    float q = 0.f;
#pragma unroll
    for (int i = 0; i < 32; ++i) { const float d = v[i] - mu; q += d * d; }
    q = wave_sum(q); rstd = 1.0f / sqrtf(q * (1.f / DM) + LN_EPS);
}
__device__ __forceinline__ void ln_mid_row(const u32x4 (&raw)[4], const float (&g)[32], const float (&b)[32], const float (&sh)[32], const float (&sc)[32], float* __restrict__ st, bf16_t* __restrict__ urow, int lane) {
    float v[32]; unpack_row(raw, v);
    float mu, rstd; stats32(v, mu, rstd);
    if (lane == 0) { float2 s2; s2.x = mu; s2.y = rstd; *(float2*)st = s2; }
#pragma unroll
    for (int i = 0; i < 32; ++i) v[i] = (v[i] - mu) * rstd * g[i] + b[i];
    float mu2, rstd2; stats32(v, mu2, rstd2);
#pragma unroll
    for (int i = 0; i < 4; ++i) { float o[8];
#pragma unroll
        for (int e = 0; e < 8; ++e) o[e] = (v[8 * i + e] - mu2) * rstd2 * (sc[8 * i + e] + 1.0f) + sh[8 * i + e];
        u32x4 w; w.x = cvt_pk_bf16(o[0], o[1]); w.y = cvt_pk_bf16(o[2], o[3]); w.z = cvt_pk_bf16(o[4], o[5]); w.w = cvt_pk_bf16(o[6], o[7]);
        *(u32x4*)(urow + i * 512 + lane * 8) = w; }
}
__device__ void phase_ln_mid(const Args& a) {
    int tid_l = threadIdx.x; asm volatile("" : "+v"(tid_l));
    const int lane = tid_l & 63, wid = tid_l >> 6;
    const float* __restrict__ mod = (const float*)(a.ws + WS_MOD); bf16_t* __restrict__ U = (bf16_t*)(a.ws + WS_ACT);
    const bf16_t* __restrict__ pre1 = (const bf16_t*)a.out; float* __restrict__ stats = (float*)(a.ws + WS_STATS);
    const int stride = gridDim.x * 8; int row = blockIdx.x * 8 + wid;
    float g[32], b[32]; ld_vec32(a.in[I_LN1G], lane, g); ld_vec32(a.in[I_LN1B], lane, b);
    u32x4 nx0[4], nx1[4];
    if (row < MTOT) { ld_row_bf16(pre1 + (size_t)row * DM, lane, nx0); ld_row_bf16(pre1 + (size_t)min(row + stride, MTOT - 1) * DM, lane, nx1); }
    for (; row < MTOT; row += 2 * stride) {
        const int row1 = row + stride;
        float sh[32], sc[32];
        const int mr0 = mod_row_of(row);
        { const float* mp = mod + (size_t)mr0 * NMOD + 3 * DM; ld_vec32(mp, lane, sh); ld_vec32(mp + DM, lane, sc); }
        u32x4 c0[4], c1[4];
#pragma unroll
        for (int i = 0; i < 4; ++i) { c0[i] = nx0[i]; c1[i] = nx1[i]; }
        ld_row_bf16(pre1 + (size_t)min(row + 2 * stride, MTOT - 1) * DM, lane, nx0); ld_row_bf16(pre1 + (size_t)min(row + 3 * stride, MTOT - 1) * DM, lane, nx1);
        ln_mid_row(c0, g, b, sh, sc, stats + (size_t)row * 2, U + (size_t)row * DM, lane);
        if (row1 < MTOT) {
            const int mr1 = mod_row_of(row1);
            if (mr1 != mr0) { const float* mp = mod + (size_t)mr1 * NMOD + 3 * DM; ld_vec32(mp, lane, sh); ld_vec32(mp + DM, lane, sc); }
            ln_mid_row(c1, g, b, sh, sc, stats + (size_t)row1 * 2, U + (size_t)row1 * DM, lane);
        }
    }
}
__device__ __forceinline__ void ln_out_row(const u32x4 (&raw)[4], const u32x4 (&praw)[4], bool has_part, const float (&g)[32], const float (&b)[32], float* __restrict__ orow, int lane) {
    float v[32]; unpack_row(raw, v);
    if (has_part) { float pp[32]; unpack_row(praw, pp);
#pragma unroll
        for (int i = 0; i < 32; ++i) v[i] += pp[i]; }
    float mu, rstd; stats32(v, mu, rstd);
#pragma unroll
    for (int i = 0; i < 4; ++i) { f32x4 o0, o1;
#pragma unroll
        for (int e = 0; e < 4; ++e) { o0[e] = (v[8 * i + e] - mu) * rstd * g[8 * i + e] + b[8 * i + e]; o1[e] = (v[8 * i + 4 + e] - mu) * rstd * g[8 * i + 4 + e] + b[8 * i + 4 + e]; }
        float* op = orow + i * 512 + lane * 8;
        *(f32x4*)op = o0; *(f32x4*)(op + 4) = o1; }
}
__device__ void phase_ln_out(const Args& a, const bf16_t* __restrict__ pre2, const bf16_t* __restrict__ part) {
    int tid_l = threadIdx.x; asm volatile("" : "+v"(tid_l));
    const int lane = tid_l & 63, wid = tid_l >> 6;
    float* __restrict__ out = a.out;
    const int stride = gridDim.x * 8; int row = blockIdx.x * 8 + wid;
    float g[32], b[32]; ld_vec32(a.in[I_LN2G], lane, g); ld_vec32(a.in[I_LN2B], lane, b);
    u32x4 nx0[4], nx1[4], np0[4], np1[4];
#pragma unroll
    for (int i = 0; i < 4; ++i) { np0[i] = (u32x4){0u, 0u, 0u, 0u}; np1[i] = np0[i]; }
#define LDROWP(nx, np, r) do { const int r_ = min((r), MTOT - 1); ld_row_bf16(pre2 + (size_t)r_ * DM, lane, nx); if (part && r_ >= 16384) ld_row_bf16(part + (size_t)(r_ - 16384) * DM, lane, np); } while (0)
    if (row < MTOT) { LDROWP(nx0, np0, row); LDROWP(nx1, np1, row + stride); }
    for (; row < MTOT; row += 2 * stride) {
        const int row1 = row + stride;
        u32x4 c0[4], c1[4], p0[4], p1[4];
#pragma unroll
        for (int i = 0; i < 4; ++i) { c0[i] = nx0[i]; c1[i] = nx1[i]; p0[i] = np0[i]; p1[i] = np1[i]; }
        LDROWP(nx0, np0, row + 2 * stride); LDROWP(nx1, np1, row + 3 * stride);
        ln_out_row(c0, p0, part && row >= 16384, g, b, out + (size_t)row * DM, lane);
        if (row1 < MTOT) ln_out_row(c1, p1, part && row1 >= 16384, g, b, out + (size_t)row1 * DM, lane);
    }
#undef LDROWP
}

__device__ __forceinline__ float row16_sum(float v) { v += dpp_f<0xB1>(v); v += dpp_f<0x4E>(v); v += dpp_f<0x141>(v); v += dpp_f<0x140>(v); return v; }
__device__ __forceinline__ float lane_xor4(float v) { return dpp_f<0x1B>(dpp_f<0x141>(v)); }
__device__ __forceinline__ void unpack8(const u32x4 w, float (&x)[8]) { x[0] = bf_lo(w.x); x[1] = bf_hi(w.x); x[2] = bf_lo(w.y); x[3] = bf_hi(w.y); x[4] = bf_lo(w.z); x[5] = bf_hi(w.z); x[6] = bf_lo(w.w); x[7] = bf_hi(w.w); }
__device__ __forceinline__ u32x4 pack8(const float (&x)[8]) { u32x4 w; w.x = cvt_pk_bf16(x[0], x[1]); w.y = cvt_pk_bf16(x[2], x[3]); w.z = cvt_pk_bf16(x[4], x[5]); w.w = cvt_pk_bf16(x[6], x[7]); return w; }
__device__ __forceinline__ void norm_rope8(float (&x)[8], const float (&gn)[8], const float (&cs)[8], const float (&sn)[8], bool lat) {
    float ss = 0.f;
#pragma unroll
    for (int e = 0; e < 8; ++e) ss += x[e] * x[e];
    ss = row16_sum(ss); const float rinv = 1.0f / sqrtf(ss * (1.f / 128.f) + LN_EPS);
#pragma unroll
    for (int e = 0; e < 8; ++e) x[e] = x[e] * rinv * gn[e];
    if (lat) {
#pragma unroll
        for (int e = 0; e < 8; ++e) { const float p = lane_xor4(x[e]); x[e] = x[e] * cs[e] + p * sn[e]; } }
}
__device__ void phase_elem(const Args& a) {
    int tid_l = threadIdx.x; asm volatile("" : "+v"(tid_l));
    const int lane = tid_l & 63, wid = tid_l >> 6;
    unsigned char* ws = a.ws;
    const bf16_t* __restrict__ PROJ = (const bf16_t*)(ws + WS_PROJ);
    bf16_t* __restrict__ KL = (bf16_t*)(ws + WS_KLAT); bf16_t* __restrict__ VL = (bf16_t*)(ws + WS_VLAT);
    bf16_t* __restrict__ KC = (bf16_t*)(ws + WS_KCTX); bf16_t* __restrict__ VC = (bf16_t*)(ws + WS_VCTX);
    const float* __restrict__ ropeC = (const float*)(ws + WS_ROPE); const float* __restrict__ ropeS = ropeC + 2048;
    float* __restrict__ ctxk = a.out + (size_t)MTOT * DM; float* __restrict__ ctxv = ctxk + (size_t)MCTX * 256;
    const int j16 = lane & 15; const bool colpart = j16 >= 8, second = (j16 & 4) != 0; const int f0 = 8 * (j16 & 3);
    float kg[8];
#pragma unroll
    for (int e = 0; e < 8; ++e) kg[e] = a.in[I_KG][8 * j16 + e];
    const int stride = gridDim.x * 8;
    for (int base = blockIdx.x * 8 + wid; base < MTOT; base += 5 * stride) {
        u32x4 c2[5]; f32x4 ca[5], cb[5], sa[5], sb[5];
#pragma unroll
        for (int k = 0; k < 5; ++k) { const int tk = min(base + k * stride, MTOT - 1);
            c2[k] = *(const u32x4*)(PROJ + (size_t)tk * NIN + 1024 + lane * 8);
            const bool latk = tk >= MCTX; const int sk = (tk - MCTX) & 4095;
            const int pos = latk ? (colpart ? (sk & 63) : (sk >> 6)) : 0;
            ca[k] = *(const f32x4*)(ropeC + pos * 32 + f0); cb[k] = *(const f32x4*)(ropeC + pos * 32 + f0 + 4); sa[k] = *(const f32x4*)(ropeS + pos * 32 + f0); sb[k] = *(const f32x4*)(ropeS + pos * 32 + f0 + 4); }
#pragma unroll
        for (int k = 0; k < 5; ++k) { const int tok = base + k * stride;
            if (tok < MTOT) {
                const bool lat = tok >= MCTX;
                int b, s; if (!lat) { b = tok >> 8; s = tok & 255; } else { const int tt = tok - MCTX; b = tt >> 12; s = tt & 4095; }
                float cs[8], sn[8];
#pragma unroll
                for (int e = 0; e < 4; ++e) { cs[e] = ca[k][e]; cs[4 + e] = cb[k][e]; sn[e] = second ? sa[k][e] : -sa[k][e]; sn[4 + e] = second ? sb[k][e] : -sb[k][e]; }
                float x2[8]; unpack8(c2[k], x2);
                float x2n[8];
#pragma unroll
                for (int e = 0; e < 8; ++e) x2n[e] = x2[e];
                norm_rope8(x2n, kg, cs, sn, lat);
                const bool isk = lane < 32;
                float kv[8];
#pragma unroll
                for (int e = 0; e < 8; ++e) kv[e] = isk ? x2n[e] : x2[e];
                const u32x4 kvw = pack8(kv);
                const int off = (lane & 31) * 8;
                if (lat) { bf16_t* dst = (isk ? KL : VL) + ((size_t)b * SKV_LAT + 512 + s) * 256 + off; *(u32x4*)dst = kvw; }
                else { bf16_t* dst = (isk ? KC : VC) + (size_t)tok * 256 + off; *(u32x4*)dst = kvw;
                    float* fo = (isk ? ctxk : ctxv) + (size_t)tok * 256 + off;
                    *(f32x4*)fo = (f32x4){kv[0], kv[1], kv[2], kv[3]}; *(f32x4*)(fo + 4) = (f32x4){kv[4], kv[5], kv[6], kv[7]}; }
            } }
    }
}
__device__ __forceinline__ void add8(float (&acc)[8], const u32x4 w, float wgt) {
    acc[0] += wgt * bf_lo(w.x); acc[1] += wgt * bf_hi(w.x); acc[2] += wgt * bf_lo(w.y); acc[3] += wgt * bf_hi(w.y);
    acc[4] += wgt * bf_lo(w.z); acc[5] += wgt * bf_hi(w.z); acc[6] += wgt * bf_lo(w.w); acc[7] += wgt * bf_hi(w.w);
}
__device__ __forceinline__ void seq_bounds(int t, int& sb, int& se) { if (t < MCTX) { sb = t & ~255; se = sb + 256; } else { sb = MCTX + ((t - MCTX) & ~4095); se = sb + 4096; } }
__device__ __forceinline__ void window_init(const bf16_t* __restrict__ pb, int cur, int half, float (&acc)[8]) {
    int sb, se; seq_bounds(cur, sb, se);
#pragma unroll
    for (int e = 0; e < 8; ++e) acc[e] = 0.f;
    for (int i = 0; i < 2 * half; ++i) { const int r = cur - half + i; const float wgt = (r >= sb && r < se) ? 1.f : 0.f; const int rc = min(max(r, sb), se - 1);
        add8(acc, *(const u32x4*)(pb + (size_t)rc * NIN), wgt); }
}
__device__ void phase_pooled(const Args& a) {
    int tid_l = threadIdx.x; asm volatile("" : "+v"(tid_l));
    const bf16_t* __restrict__ PROJ = (const bf16_t*)(a.ws + WS_PROJ); bf16_t* __restrict__ PO = (bf16_t*)(a.ws + WS_POOLED);
    constexpr int RUN = 20, NITEM = (MTOT / RUN) * 128;
    for (int item = blockIdx.x * 512 + tid_l; item < NITEM; item += gridDim.x * 512) {
        const int run = item >> 7, oct = item & 127, half = 1 << (oct >> 5);
        const int r0 = run * RUN;
        const bf16_t* pb = PROJ + 1536 + 8 * oct;
        bf16_t* ob = PO + 8 * oct;
        float acc[8];
        window_init(pb, r0, half, acc);
#pragma unroll 4
        for (int j = 0; j < RUN; ++j) {
            const int cur = r0 + j;
            int sb, se; seq_bounds(cur, sb, se);
            const int lo = max(cur - half, sb), hi = min(cur + half, se);
            const u32x4 self = *(const u32x4*)(pb + (size_t)cur * NIN);
            const int rin = cur + half, rout = cur - half;
            const u32x4 win = *(const u32x4*)(pb + (size_t)min(rin, se - 1) * NIN), wout = *(const u32x4*)(pb + (size_t)max(rout, sb) * NIN);
            const float ic = 1.0f / (float)(hi - lo);
            float sv[8]; unpack8(self, sv);
            float o[8];
#pragma unroll
            for (int e = 0; e < 8; ++e) o[e] = acc[e] * ic - sv[e];
            *(u32x4*)(ob + (size_t)cur * 1024) = pack8(o);
            if (cur + 1 < se) { add8(acc, win, rin < se ? 1.f : 0.f); add8(acc, wout, rout >= sb ? -1.f : 0.f); }
            else if (j + 1 < RUN) window_init(pb, cur + 1, half, acc);
        }
    }
}

typedef const Args __attribute__((address_space(4)))* KArgsP;
__device__ __forceinline__ Args load_args() {
    Args r;
#if defined(__HIP_DEVICE_COMPILE__)
    KArgsP p = (KArgsP)__builtin_amdgcn_kernarg_segment_ptr(); asm volatile("" : "+s"(p));
#pragma unroll
    for (int i = 0; i < 20; ++i) r.in[i] = p->in[i];
    r.out = p->out; r.ws = p->ws;
#endif
    return r;
}
#define SEAM() do { XcdBarrier xb_; { unsigned* bp_ = (unsigned*)(load_args().ws + WS_BAR); asm volatile("" : "+s"(bp_)); xb_.bar = bp_; } xb_.x = xb_xcc_id(); \
    xb_.st = (volatile LAS unsigned*)((PG8_LAS unsigned char*)shm + 131072); xcd_barrier(xb_); } while (0)
#ifndef REP_P0
#define REP_P0 1
#endif
#ifndef REP_P3B
#define REP_P3B 1
#endif
#ifndef REP_P6
#define REP_P6 1
#endif
__global__ void __launch_bounds__(512, 2) mega_fwd(Args a_unused) {
    extern __shared__ __attribute__((aligned(16))) unsigned char shm[];
    PG8_LAS unsigned char* lds3 = (PG8_LAS unsigned char*)shm;
    const int G = gridDim.x, bid = blockIdx.x;

    { const Args a = load_args();
      unsigned* barw = (unsigned*)(a.ws + WS_BAR);
      volatile LAS unsigned* bst = (volatile LAS unsigned*)(lds3 + 131072);
      if (bid == 0) for (int i = threadIdx.x; i < XCD_BAR_WORDS; i += 512) barw[i] = 0u;
      if (threadIdx.x == 0) { bst[0] = 0u; bst[1] = 0u; }
      for (int rep = 0; rep < REP_P0; ++rep) phase_prep(a, (float*)shm);
      cg::this_grid().sync();
      (void)xcd_barrier_post(barw, bst); }
    { const Args a = load_args(); phase_ln_in(a); }
    SEAM();
    { const Args a = load_args(); unsigned char* ws = a.ws;
      pg8::Gemm g{(const bf16_t*)(ws + WS_ACT), (const bf16_t*)(ws + WS_WIN), MTOT, NIN, DM, DM, DM, 0}; pg8::StaticOrder S; S.init(MTOT, NIN, G, bid);
      EpiB<0, false> E{(bf16_t*)(ws + WS_PROJ), NIN, nullptr};
      pg8::gemm_phase<EpiB<0, false>, pg8::StaticOrder>(lds3, g, S, E, nullptr);
      if (G == 256) slack_transposes(a, T_WIN, T_WIN + T_WOUT + T_FF1 + T_FF2 / 2, 32); }
    SEAM();
    { const Args a = load_args(); phase_elem(a); phase_pooled(a); }
    SEAM();
    for (int rep = 0; rep < REP_P3B; ++rep) {
        const Args a = load_args(); unsigned char* ws = a.ws;
        const att::bf16* Qb = (const att::bf16*)(ws + WS_PROJ); bf16_t* ACT = (bf16_t*)(ws + WS_ACT);
        for (int u = bid; u < 640; u += G) {
            const bool lat = u < 512; const int uu = lat ? u : u - 512;
            const int h = lat ? ((uu >> 4) & 7) : (uu & 7), b = lat ? (uu >> 7) : (uu >> 3);
            const size_t tok0 = lat ? ((size_t)MCTX + (size_t)b * 4096 + (uu & 15) * 256) : (size_t)b * 256;
            const size_t kvoff = (lat ? (size_t)b * SKV_LAT * 256 : tok0 * 256) + (h >> 2) * 128;
            const att::bf16* Kh = (const att::bf16*)(ws + (lat ? WS_KLAT : WS_KCTX)) + kvoff;
            const att::bf16* Vh = (const att::bf16*)(ws + (lat ? WS_VLAT : WS_VCTX)) + kvoff;
            __syncthreads();
            att::attn_dense_body<att::bf16>(Qb + tok0 * NIN + h * 128, Kh, Vh, ACT + tok0 * DM + h * 128, lat ? SKV_LAT : 256, (char*)shm,
                                            a.in[I_QG], (const float*)(ws + WS_ROPE), (const float*)(ws + WS_ROPE) + 2048, lat ? (uu & 15) * 256 : 0, lat);
        }
        __syncthreads();
        pg8::Gemm g{(const bf16_t*)(ws + WS_POOLED), (const bf16_t*)(ws + WS_WPOOL), MTOT, 1024, 256, 1024, 256, 512}; pg8::StaticOrder S; S.init(MTOT, 1024, G, (bid + G / 2) % G);
        EpiB<0, true> E{ACT + 1024, DM, a.in[I_PSCALE]};
        pg8::gemm_phase<EpiB<0, true>, pg8::StaticOrder>(lds3, g, S, E, nullptr);
    }
    SEAM();
    { const Args a = load_args(); unsigned char* ws = a.ws;
      pg8::Gemm g{(const bf16_t*)(ws + WS_ACT), (const bf16_t*)(ws + WS_WOUT), MTOT, DM, DM, DM, DM, 0}; pg8::StaticOrder S; S.init(MTOT, DM, G, bid);
      EpiPre1 E{a.in[I_XP], a.in[I_XS], (bf16_t*)a.out, (const float*)(ws + WS_MOD) + 2 * DM};
      pg8::gemm_phase<EpiPre1, pg8::StaticOrder>(lds3, g, S, E, nullptr);
      if (G == 256) slack_transposes(a, T_WIN + T_WOUT + T_FF1 + T_FF2 / 2, T_WIN + T_WOUT + T_FF1 + T_FF2, 128); }
    SEAM();
    { const Args a = load_args(); phase_ln_mid(a); }
    SEAM();
    for (int rep = 0; rep < REP_P6; ++rep) { const Args a = load_args(); unsigned char* ws = a.ws;
      pg8::Gemm g{(const bf16_t*)(ws + WS_ACT), (const bf16_t*)(ws + WS_WFF1), MTOT, DFF, DM, DM, DM, 0}; pg8::StaticOrder S; S.init(MTOT, DFF, G, bid);
      EpiB<1, false> E{(bf16_t*)(ws + WS_H), DFF, nullptr};
      pg8::gemm_phase<EpiB<1, false>, pg8::StaticOrder>(lds3, g, S, E, nullptr); }
    SEAM();
    { const Args a = load_args(); unsigned char* ws = a.ws;
      pg8::Gemm g{(const bf16_t*)(ws + WS_H), (const bf16_t*)(ws + WS_WFF2), MTOT, DM, DFF, DFF, DFF, 0};
      EpiPre2 E{(const bf16_t*)a.out, (const float*)(ws + WS_STATS), a.in[I_LN1G], a.in[I_LN1B], (bf16_t*)(ws + WS_ACT), (const float*)(ws + WS_MOD) + 5 * DM, (bf16_t*)(ws + WS_PART)};
      if (G == 256) { SplitOrder S; S.c = bid; pg8::gemm_phase<EpiPre2, SplitOrder>(lds3, g, S, E, nullptr); }
      else { pg8::StaticOrder S; S.init(MTOT, DM, G, bid); pg8::gemm_phase<EpiPre2, pg8::StaticOrder>(lds3, g, S, E, nullptr); } }
    SEAM();
    { const Args a = load_args(); phase_ln_out(a, (const bf16_t*)(a.ws + WS_ACT), G == 256 ? (const bf16_t*)(a.ws + WS_PART) : nullptr); }
}

extern "C" void kernel_launch(void* const* d_in, const int* in_sizes, int n_in, void* d_out, int out_size, void* d_ws, size_t ws_size, hipStream_t stream) {
    static int grid = 0;
    if (grid == 0) {
        if (n_in != 20 || ws_size < WS_END) { fprintf(stderr, "kernel_launch: need 20 inputs and %zu bytes of workspace (got %d, %zu)\n", (size_t)WS_END, n_in, ws_size); grid = -1; return; }
        int dev = 0, cus = 0, per_cu = 0;
        hipGetDevice(&dev); hipDeviceGetAttribute(&cus, hipDeviceAttributeMultiprocessorCount, dev);
        if (hipFuncSetAttribute((const void*)mega_fwd, hipFuncAttributeMaxDynamicSharedMemorySize, LDS_BYTES) != hipSuccess) { fprintf(stderr, "kernel_launch: hipFuncSetAttribute failed\n"); grid = -1; return; }
        if (hipOccupancyMaxActiveBlocksPerMultiprocessor(&per_cu, (const void*)mega_fwd, 512, LDS_BYTES) != hipSuccess || per_cu < 1) { fprintf(stderr, "kernel_launch: occupancy query says %d\n", per_cu); per_cu = 1; }
        (void)hipGetLastError();
        grid = cus * 1;
    }
    if (grid < 0) return;
    Args a{};
    for (int i = 0; i < 20; ++i) a.in[i] = (const float*)d_in[i];
    a.out = (float*)d_out; a.ws = (unsigned char*)d_ws;
    void* args[] = {&a};
    hipError_t e = hipLaunchCooperativeKernel((const void*)mega_fwd, dim3(grid), dim3(512), args, LDS_BYTES, stream);
    if (e != hipSuccess) fprintf(stderr, "kernel_launch: cooperative launch failed: %s (grid %d)\n", hipGetErrorString(e), grid);
}
```

```cpp
#include <hip/hip_runtime.h>
#include <hip/hip_bf16.h>
#include <hip/hip_cooperative_groups.h>
#include <cstdio>
#include <cstdint>
namespace cg = cooperative_groups;

constexpr int DM = 2048, MCTX = 4096, MLAT = 16384, MTOT = 20480, NIN = 2560, DFF = 8192, SKV_LAT = 4608, NMOD = 12288;
constexpr float LN_EPS = 1e-6f, ALPHA = 1.189207115002721f;
constexpr size_t al256(size_t x) { return (x + 255) / 256 * 256; }
constexpr size_t WS_WIN = 0;
constexpr size_t WS_WOUT = WS_WIN + (size_t)NIN * DM * 2;
constexpr size_t WS_WFF1 = WS_WOUT + (size_t)DM * DM * 2;
constexpr size_t WS_WFF2 = WS_WFF1 + (size_t)DFF * DM * 2;
constexpr size_t WS_WPOOL = WS_WFF2 + (size_t)DFF * DM * 2;
constexpr size_t WS_MOD = WS_WPOOL + (size_t)1024 * 256 * 2;
constexpr size_t WS_ROPE = WS_MOD + al256((size_t)5 * NMOD * 4);
constexpr size_t WS_BAR = WS_ROPE + 16384;
constexpr size_t WS_ACT = WS_BAR + 16384;
constexpr size_t WS_BIG = WS_ACT + (size_t)MTOT * DM * 2;
constexpr size_t WS_PROJ = WS_BIG;
constexpr size_t WS_Q = WS_PROJ + (size_t)MTOT * NIN * 2;
constexpr size_t WS_KLAT = WS_Q + (size_t)MTOT * 1024 * 2;
constexpr size_t WS_VLAT = WS_KLAT + (size_t)4 * SKV_LAT * 256 * 2;
constexpr size_t WS_KCTX = WS_VLAT + (size_t)4 * SKV_LAT * 256 * 2;
constexpr size_t WS_VCTX = WS_KCTX + (size_t)MCTX * 256 * 2;
constexpr size_t WS_POOLED = WS_VCTX + (size_t)MCTX * 256 * 2;
constexpr size_t WS_BIG_END1 = WS_POOLED + (size_t)MTOT * 1024 * 2;
constexpr size_t WS_H = WS_BIG;
constexpr size_t WS_STATS = WS_H + (size_t)MTOT * DFF * 2;
constexpr size_t WS_PART = WS_STATS + al256((size_t)MTOT * 2 * 4);
constexpr size_t WS_END = WS_PART + (size_t)4096 * DM * 2;
static_assert(WS_BIG_END1 <= WS_END, "aliasing");
constexpr int LDS_BYTES = 131072 + 16;

namespace pg8 {
#define PG8_LAS __attribute__((address_space(3)))
typedef unsigned short bf16_t;
typedef short bf16x8 __attribute__((ext_vector_type(8)));
typedef float f32x4 __attribute__((ext_vector_type(4)));
typedef unsigned u32x4 __attribute__((ext_vector_type(4)));
constexpr int BM = 256, BK = 64, HALF = 128, HTB = HALF * BK * 2  , STAGE_BYTES = 8 * HTB, NXCD = 8, WGM = 8;

__host__ __device__ __forceinline__ int lds_byte(int r, int c) { const int st = (r >> 4) * 2 + (c >> 5), rr = r & 15, cc = c & 31, ob = rr * 64 + cc * 2; return st * 1024 + (ob ^ (((ob >> 9) & 1) << 5)); }
__host__ __device__ __forceinline__ void stage_rc(int b, int& R, int& C) { const int st = b / 1024, sb = b % 1024, swz = sb ^ (((sb >> 9) & 1) << 5); R = (st >> 1) * 16 + swz / 64; C = (st & 1) * 32 + (swz % 64) / 2; }
__host__ __device__ __forceinline__ int perm32(int rho) { const int n = rho >> 4, i = rho & 15; return 8 * (i >> 2) + 4 * n + (i & 3); }

struct Unit { int pm, pn, kt0, nkt, ks; };
struct Gemm { const bf16_t* A; const bf16_t* Bt; int M, N, K, lda, ldb, a_pn_off; int kstepA, kstepB, tstepA_, tstepB_; };

struct StaticOrder {
    int nM, nN, nwg, G, c;
    __host__ __device__ void init(int M, int N, int G_, int c_) { nM = M / BM; nN = N / BM; nwg = nM * nN; G = G_; c = c_; }
    __host__ __device__ bool next(int i, Unit& u) const {
        const long L = (long)i * G + c; if (L >= nwg) return false;
        int wgid = (int)L; { const int q = nwg / NXCD, r = nwg % NXCD, xcd = wgid % NXCD, off = wgid / NXCD; wgid = (xcd < r ? xcd * (q + 1) : r * (q + 1) + (xcd - r) * q) + off; }
        const int nig = WGM * nN, gid = wgid / nig, fm = gid * WGM, gsz = (nM - fm) < WGM ? (nM - fm) : WGM;
        u.pm = fm + ((wgid % nig) % gsz); u.pn = (wgid % nig) / gsz; return true;
    }
    __device__ __forceinline__ void a_ready(const Unit&) const {}
    __device__ __forceinline__ void done(const Unit&) const {}
};
__device__ __forceinline__ unsigned cvt_pk_bf16(float lo, float hi) { unsigned r; asm volatile("v_cvt_pk_bf16_f32 %0, %1, %2" : "=v"(r) : "v"(lo), "v"(hi)); return r; }
template <class Epi, class Sched, bool STAMP = false>
__device__ __forceinline__ void gemm_phase(PG8_LAS unsigned char* lds, const Gemm g, const Sched& S, const Epi& E, unsigned long long* stamps) {
    int tid_l = threadIdx.x; asm volatile("" : "+v"(tid_l));
    const int tid = tid_l, wid = __builtin_amdgcn_readfirstlane(tid >> 6), lane = tid & 63, wr = wid >> 2, wc = wid & 3, fr = lane & 15, fq = lane >> 4;
    const int K = g.K, nt = K / BK;
    int ts_lo = 0, ts_hi = 0, nts = 0; const unsigned long long rt_entry = STAMP ? (unsigned long long)wall_clock64() : 0ull;
#define PG8_STAMP() do { if (STAMP && wid == 0 && nts < 64) { const unsigned long long _c = (unsigned long long)clock64(); \
        ts_lo = (lane == nts) ? (int)(unsigned)_c : ts_lo; ts_hi = (lane == nts) ? (int)(unsigned)(_c >> 32) : ts_hi; ++nts; } } while (0)
    PG8_STAMP();
    unsigned voffA[2], voffB[2];
#pragma unroll
    for (int i = 0; i < 2; ++i) { int R, C; stage_rc(tid * 16 + i * 8192, R, C); const int Rb = Epi::PERM ? ((R & ~31) + perm32(R & 31)) : R;
        voffA[i] = (unsigned)(R * g.lda + C) * 2u; voffB[i] = (unsigned)(Rb * g.ldb + C) * 2u; }
    const size_t kstepA = g.kstepA ? (size_t)g.kstepA : (size_t)(BK * 2), kstepB = g.kstepB ? (size_t)g.kstepB : (size_t)(BK * 2);
    const size_t hstepA = (size_t)HALF * g.lda * 2, hstepB = (size_t)HALF * g.ldb * 2;
    const size_t tstepA = g.tstepA_ ? (size_t)g.tstepA_ : 2 * hstepA, tstepB = g.tstepB_ ? (size_t)g.tstepB_ : 2 * hstepB;
    const unsigned ldsw = (unsigned)wid * 1024u;
    const int aoff = lds_byte(wr * 64 + fr, fq * 8), boff = lds_byte(wc * 32 + fr, fq * 8);
#define PG8_SA(b, h) (((b) * 2 + (h)) * HTB)
#define PG8_SB(b, h) ((4 + (b) * 2 + (h)) * HTB)
#define PG8_STAGE(bufoff, gbase, voff) do { _Pragma("unroll") for (int _i = 0; _i < 2; ++_i) \
        __builtin_amdgcn_global_load_lds((const unsigned*)((const char*)(gbase) + (voff)[_i]), (PG8_LAS unsigned*)(lds + (bufoff) + ldsw + _i * 8192), 16, 0, 0); } while (0)
#define PG8_LDA(dst, b, h) do { _Pragma("unroll") for (int m = 0; m < 4; ++m) _Pragma("unroll") for (int k = 0; k < 2; ++k) dst[m][k] = *(const PG8_LAS bf16x8*)(lds + PG8_SA(b, h) + aoff + m * 2048 + k * 1024); } while (0)
#define PG8_LDB(dst, b, h) do { _Pragma("unroll") for (int n = 0; n < 2; ++n) _Pragma("unroll") for (int k = 0; k < 2; ++k) dst[n][k] = *(const PG8_LAS bf16x8*)(lds + PG8_SB(b, h) + boff + n * 2048 + k * 1024); } while (0)
#define PG8_MMA(ai, bj, At, Bt) do { __builtin_amdgcn_s_setprio(1); _Pragma("unroll") for (int m = 0; m < 4; ++m) _Pragma("unroll") for (int n = 0; n < 2; ++n) _Pragma("unroll") for (int k = 0; k < 2; ++k) \
        acc[ai][bj][m][n] = __builtin_amdgcn_mfma_f32_16x16x32_bf16(Bt[n][k], At[m][k], acc[ai][bj][m][n], 0, 0, 0); __builtin_amdgcn_s_setprio(0); } while (0)
#define PG8_WAIT_V(n) asm volatile("s_waitcnt vmcnt(" #n ")" ::: "memory")
#define PG8_WAIT_L(n) asm volatile("s_waitcnt lgkmcnt(" #n ")" ::: "memory")
#define PG8_BAR __builtin_amdgcn_s_barrier()
#define PG8_SCHED __builtin_amdgcn_sched_barrier(0)
    Unit cur, nxt; int ui = 0; cur.kt0 = 0; cur.nkt = nt; cur.ks = 0;
    if (!S.next(0, cur)) return;
    f32x4 acc[2][2][4][2];
#pragma unroll
    for (int a = 0; a < 2; ++a)
#pragma unroll
        for (int b = 0; b < 2; ++b)
#pragma unroll
            for (int m = 0; m < 4; ++m)
#pragma unroll
                for (int n = 0; n < 2; ++n) acc[a][b][m][n] = (f32x4){0.f, 0.f, 0.f, 0.f};
    bf16x8 At[4][2], B0[2][2], B1[2][2];
    const char* cA = (const char*)g.A + (size_t)cur.pm * tstepA + (size_t)cur.pn * g.a_pn_off + (size_t)cur.kt0 * kstepA; const char* cB = (const char*)g.Bt + (size_t)cur.pn * tstepB + (size_t)cur.kt0 * kstepB;
    S.a_ready(cur);
    PG8_STAGE(PG8_SB(0, 0), cB, voffB); PG8_STAGE(PG8_SA(0, 0), cA, voffA); PG8_STAGE(PG8_SB(0, 1), cB + hstepB, voffB); PG8_STAGE(PG8_SA(0, 1), cA + hstepA, voffA);
    if (wr == 1) PG8_BAR;
    PG8_WAIT_V(4); PG8_BAR;
    PG8_STAGE(PG8_SB(1, 0), cB + kstepB, voffB); PG8_STAGE(PG8_SA(1, 0), cA + kstepA, voffA); PG8_STAGE(PG8_SB(1, 1), cB + hstepB + kstepB, voffB);
    PG8_WAIT_V(6); PG8_BAR;
    PG8_STAMP();
    for (;;) {
        nxt.kt0 = 0; nxt.nkt = nt; nxt.ks = 0;
        const bool has_next = S.next(ui + 1, nxt);
        const char* nA = has_next ? (const char*)g.A + (size_t)nxt.pm * tstepA + (size_t)nxt.pn * g.a_pn_off + (size_t)nxt.kt0 * kstepA : cA; const char* nB = has_next ? (const char*)g.Bt + (size_t)nxt.pn * tstepB + (size_t)nxt.kt0 * kstepB : cB;
        const int cnt = cur.nkt;
        for (int t = 0; t < cnt; t += 2) {
            const bool last = (t == cnt - 2);
            const char* a1 = cA + (size_t)(t + 1) * kstepA;
            const char* a2 = last ? nA : cA + (size_t)(t + 2) * kstepA; const char* b2 = last ? nB : cB + (size_t)(t + 2) * kstepB;
            const char* a3 = a2 + kstepA; const char* b3 = b2 + kstepB;
            if (last && has_next) S.a_ready(nxt);
            PG8_LDB(B0, 0, 0); PG8_SCHED; PG8_LDA(At, 0, 0); PG8_STAGE(PG8_SA(1, 1), a1 + hstepA, voffA);
            PG8_WAIT_L(8); PG8_BAR; PG8_WAIT_L(0); PG8_MMA(0, 0, At, B0); PG8_BAR; PG8_SCHED;
            PG8_LDB(B1, 0, 1); PG8_STAGE(PG8_SB(0, 0), b2, voffB);
            PG8_BAR; PG8_WAIT_L(0); PG8_MMA(0, 1, At, B1); PG8_BAR;
            PG8_LDA(At, 0, 1); PG8_STAGE(PG8_SA(0, 0), a2, voffA);
            PG8_BAR; PG8_WAIT_L(0); PG8_MMA(1, 0, At, B0); PG8_BAR; PG8_SCHED;
            PG8_STAGE(PG8_SB(0, 1), b2 + hstepB, voffB);
            PG8_WAIT_V(6); PG8_BAR; PG8_MMA(1, 1, At, B1); PG8_BAR;
            PG8_LDB(B0, 1, 0); PG8_SCHED; PG8_LDA(At, 1, 0); PG8_STAGE(PG8_SA(0, 1), a2 + hstepA, voffA);
            PG8_WAIT_L(8); PG8_BAR; PG8_WAIT_L(0); PG8_MMA(0, 0, At, B0); PG8_BAR; PG8_SCHED;
            PG8_LDB(B1, 1, 1); PG8_STAGE(PG8_SB(1, 0), b3, voffB);
            PG8_BAR; PG8_WAIT_L(0); PG8_MMA(0, 1, At, B1); PG8_BAR;
            PG8_LDA(At, 1, 1); PG8_STAGE(PG8_SA(1, 0), a3, voffA);
            PG8_BAR; PG8_WAIT_L(0); PG8_MMA(1, 0, At, B0); PG8_BAR; PG8_SCHED;
            PG8_STAGE(PG8_SB(1, 1), b3 + hstepB, voffB);
            PG8_WAIT_V(6); PG8_BAR; PG8_MMA(1, 1, At, B1); PG8_BAR;
        }
        PG8_STAMP();
        if constexpr (!Epi::AFTER_DRAIN) { E(acc, cur, wr, wc, fr, fq); S.done(cur); }
        PG8_STAMP();
        if (!has_next) break;
#pragma unroll
        for (int a = 0; a < 2; ++a)
#pragma unroll
            for (int b = 0; b < 2; ++b)
#pragma unroll
                for (int m = 0; m < 4; ++m)
#pragma unroll
                    for (int n = 0; n < 2; ++n) acc[a][b][m][n] = (f32x4){0.f, 0.f, 0.f, 0.f};
        cur = nxt; cA = nA; cB = nB; ++ui;
    }
    PG8_WAIT_V(0);
    if (wr == 0) PG8_BAR;
    PG8_BAR;
    if constexpr (Epi::AFTER_DRAIN) { E.fused(acc, cur, wr, wc, fr, fq, lds, wid, lane); S.done(cur); }
    PG8_STAMP();
    if (STAMP && wid == 0) { stamps[lane] = lane < nts ? (((unsigned long long)(unsigned)ts_hi << 32) | (unsigned)ts_lo) : 0ull;
        if (lane == 62) stamps[62] = rt_entry; if (lane == 63) stamps[63] = (unsigned long long)wall_clock64(); }
#undef PG8_STAMP
#undef PG8_SA
#undef PG8_SB
#undef PG8_STAGE
#undef PG8_LDA
#undef PG8_LDB
#undef PG8_MMA
#undef PG8_WAIT_V
#undef PG8_WAIT_L
#undef PG8_BAR
#undef PG8_SCHED
}
}
namespace att {
using bf16 = __hip_bfloat16;
constexpr int   D = 128, NW = 8, QBLK = 32, KVBLK = 64;
constexpr float SCALE = 0.088388347648318440f;
constexpr float THR = 8.f;
#ifndef ATT_SDEPTH
#define ATT_SDEPTH 2
#endif
constexpr int SDEPTH = ATT_SDEPTH;
constexpr int LDQ = 2560, LDK = 256, LDO = 2048;
constexpr size_t SHM_V = KVBLK * D * 2, SHM_K = KVBLK * D * 2, SHM_ATTN = 2 * SHM_V + 2 * SHM_K + NW * 64 * 4;
using bf16x8 = __attribute__((ext_vector_type(8))) short;
using s16x4  = __attribute__((ext_vector_type(4))) short;
using f32x16 = __attribute__((ext_vector_type(16))) float;
using f32x8  = __attribute__((ext_vector_type(8))) float;
using u32x4  = __attribute__((ext_vector_type(4))) unsigned;
#define KSWZ(row, colB) ((row) * 256 + ((colB) ^ (((row) & 7) << 4)))
#define SBAR() __builtin_amdgcn_sched_barrier(0)
__device__ __forceinline__ int crow(int r, int hi) { return (r & 3) + 8 * (r >> 2) + 4 * hi; }
__device__ __forceinline__ unsigned cvtpk(float lo, float hi) {
  unsigned r; asm volatile("v_cvt_pk_bf16_f32 %0, %1, %2" : "=v"(r) : "v"(lo), "v"(hi)); return r;
}
template <typename TIn> struct Stage;
template <> struct Stage<bf16>  { using T = bf16x8;
  __device__ static __forceinline__ T ld8(const bf16* p) { return *reinterpret_cast<const bf16x8*>(p); }
  __device__ static __forceinline__ bf16x8 tobf(T x) { return x; } };
template <> struct Stage<float> { using T = f32x8;
  __device__ static __forceinline__ T ld8(const float* p) { return *reinterpret_cast<const f32x8*>(p); }
  __device__ static __forceinline__ bf16x8 tobf(T x) {
    u32x4 w = {cvtpk(x[0], x[1]), cvtpk(x[2], x[3]), cvtpk(x[4], x[5]), cvtpk(x[6], x[7])}; return *reinterpret_cast<bf16x8*>(&w); } };

__device__ __forceinline__ void partialSM(f32x16& p0, f32x16& p1, float& m_reg, float& mn, float& alpha) {
  constexpr float C = SCALE * 1.4426950408889634f;
  float pmax = p0[0]; for (int r = 1; r < 16; ++r) pmax = fmaxf(pmax, p0[r]); for (int r = 0; r < 16; ++r) pmax = fmaxf(pmax, p1[r]);
  { auto rr = __builtin_amdgcn_permlane32_swap(__float_as_uint(pmax), __float_as_uint(pmax), false, false);
    pmax = fmaxf(__uint_as_float(rr[0]), __uint_as_float(rr[1])); }
  if (__builtin_expect(__all(pmax - m_reg <= THR / SCALE), 1)) { mn = m_reg; alpha = 1.f; }
  else { mn = fmaxf(m_reg, pmax); alpha = __builtin_amdgcn_exp2f((m_reg - mn) * C); m_reg = mn; }
  float mnC = -mn * C;
  for (int r = 0; r < 16; ++r) p0[r] = fmaf(p0[r], C, mnC); for (int r = 0; r < 16; ++r) p1[r] = fmaf(p1[r], C, mnC);
  for (int r = 0; r < 16; ++r) p0[r] = __builtin_amdgcn_exp2f(p0[r]);
}
__device__ __forceinline__ void finishSM(f32x16& p0, f32x16& p1, float alpha, float& l_reg, bf16x8& pa0, bf16x8& pa1, bf16x8& pa2, bf16x8& pa3) {
  for (int r = 0; r < 16; ++r) p1[r] = __builtin_amdgcn_exp2f(p1[r]);
  float ps = 0; for (int r = 0; r < 16; ++r) ps += p0[r]; for (int r = 0; r < 16; ++r) ps += p1[r];
  { auto rr = __builtin_amdgcn_permlane32_swap(__float_as_uint(ps), __float_as_uint(ps), false, false);
    ps = __uint_as_float(rr[0]) + __uint_as_float(rr[1]); }
  l_reg = l_reg * alpha + ps;
#define PK4(P, BASE, OUT) do { unsigned a0 = cvtpk(P[BASE + 0], P[BASE + 1]), a1 = cvtpk(P[BASE + 2], P[BASE + 3]);   \
    unsigned b0 = cvtpk(P[BASE + 4], P[BASE + 5]), b1 = cvtpk(P[BASE + 6], P[BASE + 7]);                              \
    auto r0 = __builtin_amdgcn_permlane32_swap(a0, b0, false, false); auto r1 = __builtin_amdgcn_permlane32_swap(a1, b1, false, false); \
    u32x4 w = {r0[0], r1[0], r0[1], r1[1]}; OUT = *reinterpret_cast<bf16x8*>(&w); } while (0)
  PK4(p0, 0, pa0); PK4(p0, 8, pa1); PK4(p1, 0, pa2); PK4(p1, 8, pa3);
#undef PK4
}
__device__ __forceinline__ void qkt(f32x16& p0, f32x16& p1, const bf16* Ks, const bf16x8* qr, int r32, int hi) {
  p0 = f32x16{}; p1 = f32x16{};
  for (int d0 = 0; d0 < 8; ++d0) { int cb = (d0 * 16 + hi * 8) * 2;
    bf16x8 b0 = *reinterpret_cast<const bf16x8*>((const char*)Ks + KSWZ(r32, cb));
    bf16x8 b1 = *reinterpret_cast<const bf16x8*>((const char*)Ks + KSWZ(32 + r32, cb));
    p0 = __builtin_amdgcn_mfma_f32_32x32x16_bf16(b0, qr[d0], p0, 0, 0, 0);
    p1 = __builtin_amdgcn_mfma_f32_32x32x16_bf16(b1, qr[d0], p1, 0, 0, 0); }
}
__device__ __forceinline__ int v_st(int k, int c) { const int kk = (k & ~0xC) | ((k & 4) << 1) | ((k & 8) >> 1); return ((kk >> 3) * 4 + (c >> 5)) * 512 + ((kk & 7) * 32 + (c & 31)) * 2; }
__device__ __forceinline__ int v_rd_base(int lane) { return ((lane & 3) << 3) | (((lane >> 2) & 3) << 6) | (((lane >> 4) & 1) << 5) | (((lane >> 5) & 1) << 8); }
constexpr int v_rd_off(int d0, int ks, int half) { return d0 * 512 + ks * 4096 + half * 2048; }
template <int OFF> __device__ __forceinline__ s16x4 tr_read(int vb) {
  s16x4 r; asm volatile("ds_read_b64_tr_b16 %0, %1 offset:%2" : "=&v"(r) : "v"(vb), "i"(OFF) : "memory"); return r;
}
template <int D0> __device__ __forceinline__ void pv_one(f32x16& od, int vb, bf16x8 pa0, bf16x8 pa1, bf16x8 pa2, bf16x8 pa3) {
  const s16x4 l0 = tr_read<v_rd_off(D0, 0, 0)>(vb), h0 = tr_read<v_rd_off(D0, 0, 1)>(vb), l1 = tr_read<v_rd_off(D0, 1, 0)>(vb), h1 = tr_read<v_rd_off(D0, 1, 1)>(vb);
  const s16x4 l2 = tr_read<v_rd_off(D0, 2, 0)>(vb), h2 = tr_read<v_rd_off(D0, 2, 1)>(vb), l3 = tr_read<v_rd_off(D0, 3, 0)>(vb), h3 = tr_read<v_rd_off(D0, 3, 1)>(vb);
  asm volatile("s_waitcnt lgkmcnt(0)" ::: "memory"); SBAR();
#define PK(L, H) (bf16x8){L[0], L[1], L[2], L[3], H[0], H[1], H[2], H[3]}
  od = __builtin_amdgcn_mfma_f32_32x32x16_bf16(pa0, PK(l0, h0), od, 0, 0, 0);
  od = __builtin_amdgcn_mfma_f32_32x32x16_bf16(pa1, PK(l1, h1), od, 0, 0, 0);
  od = __builtin_amdgcn_mfma_f32_32x32x16_bf16(pa2, PK(l2, h2), od, 0, 0, 0);
  od = __builtin_amdgcn_mfma_f32_32x32x16_bf16(pa3, PK(l3, h3), od, 0, 0, 0);
#undef PK
}
__device__ __forceinline__ void pv_d0(f32x16* o, int vb, bf16x8 pa0, bf16x8 pa1, bf16x8 pa2, bf16x8 pa3) {
  pv_one<0>(o[0], vb, pa0, pa1, pa2, pa3); pv_one<1>(o[1], vb, pa0, pa1, pa2, pa3); pv_one<2>(o[2], vb, pa0, pa1, pa2, pa3); pv_one<3>(o[3], vb, pa0, pa1, pa2, pa3);
}

template <typename TQ>
__device__ __forceinline__ void attn_dense_body(const TQ* __restrict__ Qb, const bf16* __restrict__ Kh, const bf16* __restrict__ Vh,
                                                unsigned short* __restrict__ Ob, int seq, char* lds,
                                                const float* __restrict__ qgain, const float* __restrict__ ropeC, const float* __restrict__ ropeS, int s0, bool lat) {
  using St = Stage<bf16>; using SQ = Stage<TQ>;
  int tid_l = threadIdx.x; asm volatile("" : "+v"(tid_l));
  const int tid = tid_l, wid = tid >> 6, lane = tid & 63, r32 = lane & 31, hi = lane >> 5;
  bf16* V_lds = (bf16*)lds; bf16* K_lds = (bf16*)(lds + 2 * SHM_V);
  float* ws = (float*)(lds + 2 * SHM_V + 2 * SHM_K) + wid * 64; float* li_l = ws; float* al_l = ws + 32;
  float m_reg = -1e30f, l_reg = 0; f32x16 o[4] = {}; bf16x8 qr[8];
  const TQ* Qw = Qb + (long)(wid * QBLK + r32) * LDQ + hi * 8;
#pragma unroll
  for (int d0 = 0; d0 < 8; ++d0) qr[d0] = SQ::tobf(SQ::ld8(Qw + d0 * 16));
  {
    float xq[8][8];
#pragma unroll
    for (int d0 = 0; d0 < 8; ++d0) { const u32x4 w = *reinterpret_cast<const u32x4*>(&qr[d0]);
      xq[d0][0] = __uint_as_float(w.x << 16); xq[d0][1] = __uint_as_float(w.x & 0xffff0000u); xq[d0][2] = __uint_as_float(w.y << 16); xq[d0][3] = __uint_as_float(w.y & 0xffff0000u);
      xq[d0][4] = __uint_as_float(w.z << 16); xq[d0][5] = __uint_as_float(w.z & 0xffff0000u); xq[d0][6] = __uint_as_float(w.w << 16); xq[d0][7] = __uint_as_float(w.w & 0xffff0000u); }
    float ss = 0.f;
#pragma unroll
    for (int d0 = 0; d0 < 8; ++d0)
#pragma unroll
      for (int e = 0; e < 8; ++e) ss += xq[d0][e] * xq[d0][e];
    { auto rr = __builtin_amdgcn_permlane32_swap(__float_as_uint(ss), __float_as_uint(ss), false, false); ss = __uint_as_float(rr[0]) + __uint_as_float(rr[1]); }
    const float rinv = 1.0f / sqrtf(ss * (1.f / 128.f) + 1e-6f);
#pragma unroll
    for (int d0 = 0; d0 < 8; ++d0) { const float* gp = qgain + d0 * 16 + hi * 8;
      const float4 g0 = *reinterpret_cast<const float4*>(gp), g1 = *reinterpret_cast<const float4*>(gp + 4);
      xq[d0][0] *= rinv * g0.x; xq[d0][1] *= rinv * g0.y; xq[d0][2] *= rinv * g0.z; xq[d0][3] *= rinv * g0.w;
      xq[d0][4] *= rinv * g1.x; xq[d0][5] *= rinv * g1.y; xq[d0][6] *= rinv * g1.z; xq[d0][7] *= rinv * g1.w; }
    if (lat) {
      const int spos = s0 + wid * QBLK + r32;
#pragma unroll
      for (int part = 0; part < 2; ++part) { const int pos = part ? (spos & 63) : (spos >> 6);
#pragma unroll
        for (int q2 = 0; q2 < 2; ++q2) { const int a = part * 4 + q2, b = a + 2; const int fi0 = q2 * 16 + hi * 8;
          const float* cp = ropeC + pos * 32 + fi0; const float* sp = ropeS + pos * 32 + fi0;
          const float4 c0 = *reinterpret_cast<const float4*>(cp), c1 = *reinterpret_cast<const float4*>(cp + 4), n0 = *reinterpret_cast<const float4*>(sp), n1 = *reinterpret_cast<const float4*>(sp + 4);
          const float cc[8] = {c0.x, c0.y, c0.z, c0.w, c1.x, c1.y, c1.z, c1.w}, sn[8] = {n0.x, n0.y, n0.z, n0.w, n1.x, n1.y, n1.z, n1.w};
#pragma unroll
          for (int e = 0; e < 8; ++e) { const float x1 = xq[a][e], x2 = xq[b][e]; xq[a][e] = x1 * cc[e] - x2 * sn[e]; xq[b][e] = x2 * cc[e] + x1 * sn[e]; } } }
    }
#pragma unroll
    for (int d0 = 0; d0 < 8; ++d0) { u32x4 w = {cvtpk(xq[d0][0], xq[d0][1]), cvtpk(xq[d0][2], xq[d0][3]), cvtpk(xq[d0][4], xq[d0][5]), cvtpk(xq[d0][6], xq[d0][7])}; qr[d0] = *reinterpret_cast<bf16x8*>(&w); }
  }
  const int sr = tid >> 4, sc = (tid & 15) * 8, vst0 = v_st(sr, sc), vst1 = v_st(32 + sr, sc);
  const int vb0 = (int)(uintptr_t)V_lds + v_rd_base(lane);
  struct { typename St::T vs0, vs1, ks0, ks1; } sr_[SDEPTH];
#define SLOAD(i, k0) do { sr_[i].vs0 = St::ld8(&Vh[(long)((k0) + sr) * LDK + sc]); sr_[i].vs1 = St::ld8(&Vh[(long)((k0) + 32 + sr) * LDK + sc]); \
    sr_[i].ks0 = St::ld8(&Kh[(long)((k0) + sr) * LDK + sc]); sr_[i].ks1 = St::ld8(&Kh[(long)((k0) + 32 + sr) * LDK + sc]); } while (0)
#define SWRITE(b, i) do { *(bf16x8*)((char*)V_lds + (b) * SHM_V + vst0) = St::tobf(sr_[i].vs0);          \
    *(bf16x8*)((char*)V_lds + (b) * SHM_V + vst1) = St::tobf(sr_[i].vs1); int kc = sc * 2;               \
    *(bf16x8*)((char*)K_lds + (b) * SHM_K + KSWZ(sr, kc)) = St::tobf(sr_[i].ks0);                       \
    *(bf16x8*)((char*)K_lds + (b) * SHM_K + KSWZ(32 + sr, kc)) = St::tobf(sr_[i].ks1); } while (0)
#define SWAIT() do { if constexpr (SDEPTH == 2) asm volatile("s_waitcnt vmcnt(4)" ::: "memory"); else asm volatile("s_waitcnt vmcnt(0)" ::: "memory"); } while (0)
#define RESC(a) do { if (__any((a) < 1.f)) { if (hi == 0) al_l[r32] = (a); asm volatile("s_waitcnt lgkmcnt(0)" ::: "memory"); \
    for (int d = 0; d < 4; ++d) for (int r = 0; r < 16; ++r) o[d][r] *= al_l[crow(r, hi)]; } } while (0)
  f32x16 pA0, pA1, pB0, pB1; float mnA, mnB, alA, alB; bf16x8 pa0, pa1, pa2, pa3; const int NT = seq / KVBLK;
  constexpr int SE = 0, SO = SDEPTH - 1;
  SLOAD(SE, 0); asm volatile("s_waitcnt vmcnt(0)" ::: "memory"); SWRITE(0, SE); __syncthreads();
  qkt(pA0, pA1, K_lds, qr, r32, hi); partialSM(pA0, pA1, m_reg, mnA, alA);
  SLOAD(SO, KVBLK); if constexpr (SDEPTH == 2) { if (2 < NT) SLOAD(SE, 2 * KVBLK); }
  SWAIT(); SWRITE(1, SO); __syncthreads();
  for (int j = 1; j + 1 < NT; j += 2) {
    SBAR(); qkt(pB0, pB1, (bf16*)((char*)K_lds + SHM_K), qr, r32, hi);
    finishSM(pA0, pA1, alA, l_reg, pa0, pa1, pa2, pa3); SBAR();
    SLOAD(SO, (j + SDEPTH) * KVBLK); SBAR();
    pv_d0(o, vb0, pa0, pa1, pa2, pa3); partialSM(pB0, pB1, m_reg, mnB, alB);
    __syncthreads(); SWAIT(); SWRITE(0, SE);
    RESC(alB); __syncthreads();
    SBAR(); qkt(pA0, pA1, K_lds, qr, r32, hi);
    finishSM(pB0, pB1, alB, l_reg, pa0, pa1, pa2, pa3); SBAR();
    if (SDEPTH == 1 || j + 3 < NT) SLOAD(SE, (j + 1 + SDEPTH) * KVBLK); SBAR();
    pv_d0(o, vb0 + (int)SHM_V, pa0, pa1, pa2, pa3); partialSM(pA0, pA1, m_reg, mnA, alA);
    __syncthreads(); SWAIT(); SWRITE(1, SO);
    RESC(alA); __syncthreads();
  }
  SBAR(); qkt(pB0, pB1, (bf16*)((char*)K_lds + SHM_K), qr, r32, hi);
  finishSM(pA0, pA1, alA, l_reg, pa0, pa1, pa2, pa3); SBAR();
  pv_d0(o, vb0, pa0, pa1, pa2, pa3); partialSM(pB0, pB1, m_reg, mnB, alB);
  __syncthreads(); RESC(alB);
  finishSM(pB0, pB1, alB, l_reg, pa0, pa1, pa2, pa3); SBAR();
  pv_d0(o, vb0 + (int)SHM_V, pa0, pa1, pa2, pa3);
  if (hi == 0) li_l[r32] = l_reg; asm volatile("s_waitcnt lgkmcnt(0)" ::: "memory");
  float rli[16];
#pragma unroll
  for (int r = 0; r < 16; ++r) rli[r] = __builtin_amdgcn_rcpf(li_l[crow(r, hi)]);
  unsigned short* Ow = Ob + (long)(wid * QBLK) * LDO;
#pragma unroll
  for (int r = 0; r < 16; ++r) { int orow = crow(r, hi);
    for (int d0 = 0; d0 < 4; ++d0) Ow[(long)orow * LDO + d0 * 32 + r32] = (unsigned short)(cvtpk(o[d0][r] * rli[r], 0.f) & 0xffffu); }
#undef SLOAD
#undef SWRITE
#undef SWAIT
#undef RESC
}
}
#define XB_TMO      128
#define XB_XCNT(j)  (256  + 64 * (j))
#define XB_XSUB(j)  (1280 + 64 * (j))
#define XB_XGEN(j)  (2304 + 64 * (j))
#define XB_TOP      3328
#define XB_TOPGEN   3392
#define XCD_BAR_WORDS 3456
#define XB_SPIN_CAP (1u << 18)
#define LAS __attribute__((address_space(3)))

__device__ __forceinline__ unsigned xb_ld(unsigned* p)              { return __hip_atomic_load(p, __ATOMIC_RELAXED, __HIP_MEMORY_SCOPE_AGENT); }
__device__ __forceinline__ unsigned xb_add(unsigned* p, unsigned v) { return __hip_atomic_fetch_add(p, v, __ATOMIC_RELAXED, __HIP_MEMORY_SCOPE_AGENT); }
__device__ __forceinline__ unsigned xb_xcc_id() { return (unsigned)__builtin_amdgcn_s_getreg((3 << 11) | 20) & 0xFu; }
#define XB_SPIN(cond, bar) do { unsigned _sp = 0; while (cond) { __builtin_amdgcn_s_sleep(1); \
    if ((++_sp & 255u) == 0u) { if (xb_ld(&(bar)[XB_TMO])) break; if (_sp > XB_SPIN_CAP) { atomicAdd(&(bar)[XB_TMO], 1u); break; } } } } while (0)

struct XcdBarrier {
    unsigned* bar; unsigned x;
    volatile LAS unsigned* st;
};

__device__ __forceinline__ XcdBarrier xcd_barrier_post(unsigned* bar, volatile LAS unsigned* st) {
    XcdBarrier b; b.bar = bar; b.x = xb_xcc_id(); b.st = st;
    if (threadIdx.x == 0) (void)xb_add(&bar[XB_XCNT(b.x)], 1u);
    return b;
}
__device__ __forceinline__ void xcd_barrier_complete(unsigned* bar, unsigned x, unsigned& nloc, unsigned& nx) {
    const unsigned G = gridDim.x * gridDim.y * gridDim.z;
    unsigned sum, cnt, mine, sp = 0u;
    for (;;) {
        sum = 0u; cnt = 0u; mine = 0u;
#pragma unroll
        for (unsigned j = 0; j < 16; ++j) { const unsigned c = xb_ld(&bar[XB_XCNT(j)]); sum += c; cnt += (c > 0u) ? 1u : 0u; mine = (j == x) ? c : mine; }
        if (sum == G) break;
        __builtin_amdgcn_s_sleep(1);
        if ((++sp & 255u) == 0u) { if (xb_ld(&bar[XB_TMO])) break; if (sp > XB_SPIN_CAP) { atomicAdd(&bar[XB_TMO], 1u); break; } }
    }
    nloc = mine > 0u ? mine : 1u; nx = cnt > 0u ? cnt : 1u;
}

__device__ __forceinline__ void xcd_barrier(const XcdBarrier& b) {
    asm volatile("s_waitcnt vmcnt(0)" ::: "memory");
    __syncthreads();
    if (threadIdx.x == 0) {
        unsigned* bar = b.bar;
        __builtin_amdgcn_s_waitcnt(0);
        unsigned nloc = b.st[0], nx = b.st[1];
        if (nloc == 0u) { xcd_barrier_complete(bar, b.x, nloc, nx); b.st[0] = nloc; b.st[1] = nx; }
        const unsigned old = xb_add(&bar[XB_XSUB(b.x)], 1u);
        const unsigned gen = old / nloc;
        if (old + 1u == (gen + 1u) * nloc) {
            __builtin_amdgcn_fence(__ATOMIC_RELEASE, "agent");
            asm volatile("s_waitcnt vmcnt(0)" ::: "memory");
            const unsigned og = xb_add(&bar[XB_TOP], 1u);
            const unsigned tg = og / nx;
            if (og + 1u == (tg + 1u) * nx) xb_add(&bar[XB_TOPGEN], 1u);
            else XB_SPIN(xb_ld(&bar[XB_TOPGEN]) == tg, bar);
            __builtin_amdgcn_fence(__ATOMIC_ACQUIRE, "agent");
            xb_add(&bar[XB_XGEN(b.x)], 1u);
            asm volatile("s_waitcnt vmcnt(0)" ::: "memory");
        } else {
            XB_SPIN(xb_ld(&bar[XB_XGEN(b.x)]) == gen, bar);
            __builtin_amdgcn_fence(__ATOMIC_ACQUIRE, "agent");
            asm volatile("s_waitcnt vmcnt(0)" ::: "memory");
        }
    }
    __syncthreads();
}


using pg8::bf16_t; using pg8::f32x4; using pg8::u32x4; using pg8::Unit; using pg8::cvt_pk_bf16;
typedef unsigned u32x2 __attribute__((ext_vector_type(2)));
struct Args { const float* in[20]; float* out; unsigned char* ws; };
enum { I_XP = 0, I_XS, I_CK, I_CV, I_C, I_CCTX, I_WMOD, I_BMOD, I_WIN, I_QG, I_KG, I_WPOOL, I_PSCALE, I_WOUT, I_LN1G, I_LN1B, I_WFF1, I_WFF2, I_LN2G, I_LN2B };

template <int CTRL> __device__ __forceinline__ float dpp_f(float v) { return __int_as_float(__builtin_amdgcn_update_dpp(0, __float_as_int(v), CTRL, 0xF, 0xF, true)); }
__device__ __forceinline__ float wave_sum(float v) {
    v += dpp_f<0xB1>(v); v += dpp_f<0x4E>(v); v += dpp_f<0x141>(v); v += dpp_f<0x140>(v);
    { auto r = __builtin_amdgcn_permlane16_swap(__float_as_uint(v), __float_as_uint(v), false, false); v = __uint_as_float(r[0]) + __uint_as_float(r[1]); }
    { auto r = __builtin_amdgcn_permlane32_swap(__float_as_uint(v), __float_as_uint(v), false, false); v = __uint_as_float(r[0]) + __uint_as_float(r[1]); }
    return v;
}
__device__ __forceinline__ float bf_lo(unsigned w) { return __uint_as_float(w << 16); }
__device__ __forceinline__ float bf_hi(unsigned w) { return __uint_as_float(w & 0xffff0000u); }
__device__ __forceinline__ int mod_row_of(int row) { return row < MCTX ? 4 : ((row - MCTX) >> 12); }
__device__ __forceinline__ const float* x_row(const Args& a, int row) { return row < MCTX ? a.in[I_XP] + (size_t)row * DM : a.in[I_XS] + (size_t)(row - MCTX) * DM; }

template <int ACT  , bool CS  > struct EpiB {
    static constexpr bool PERM = true, AFTER_DRAIN = false;
    bf16_t* O; int ldc; const float* cs;
    __device__ __forceinline__ void operator()(const f32x4 (&acc)[2][2][4][2], const Unit& u, int wr, int wc, int fr, int fq) const {
        const int row0 = u.pm * 256 + wr * 64 + fr, col0 = u.pn * 256 + wc * 32 + 8 * fq;
#pragma unroll
        for (int bj = 0; bj < 2; ++bj) {
            f32x4 sv0 = {1.f, 1.f, 1.f, 1.f}, sv1 = sv0;
            if (CS) { sv0 = *(const f32x4*)(cs + col0 + bj * 128); sv1 = *(const f32x4*)(cs + col0 + bj * 128 + 4); }
#pragma unroll
            for (int ai = 0; ai < 2; ++ai)
#pragma unroll
                for (int m = 0; m < 4; ++m) { const int rr = row0 + ai * 128 + m * 16, cc = col0 + bj * 128;
                    bf16_t* rowp = (ACT == 1) ? O + ((((size_t)(rr >> 8) * (DFF / 64) + (cc >> 6)) * 256 + (rr & 255)) * 64 + (cc & 63))
                                            : O + (size_t)rr * ldc + cc;
                    f32x4 v0 = acc[ai][bj][m][0], v1 = acc[ai][bj][m][1];
                    if (ACT == 1) {
#pragma unroll
                        for (int j = 0; j < 4; ++j) { const float r0 = fmaxf(v0[j], 0.f), r1 = fmaxf(v1[j], 0.f); v0[j] = r0 * r0; v1[j] = r1 * r1; } }
                    if (CS) { v0 = v0 * sv0; v1 = v1 * sv1; }
                    u32x4 w; w.x = cvt_pk_bf16(v0[0], v0[1]); w.y = cvt_pk_bf16(v0[2], v0[3]); w.z = cvt_pk_bf16(v1[0], v1[1]); w.w = cvt_pk_bf16(v1[2], v1[3]);
                    *(u32x4*)rowp = w; }
            asm volatile("" ::: "memory");
        }
    }
};
struct EpiPre1 {
    static constexpr bool PERM = true, AFTER_DRAIN = false;
    const float* __restrict__ xp; const float* __restrict__ xs; bf16_t* __restrict__ pre; const float* __restrict__ gate;
    __device__ __forceinline__ void operator()(const f32x4 (&acc)[2][2][4][2], const Unit& u, int wr, int wc, int fr, int fq) const {
        const int row0 = u.pm * 256 + wr * 64 + fr, col0 = u.pn * 256 + wc * 32 + 8 * fq;
        const int mrow = u.pm < 16 ? 4 : ((u.pm - 16) >> 4);
        const float* gp = gate + (size_t)mrow * NMOD + col0;
        f32x4 gv[2][2];
#pragma unroll
        for (int bj = 0; bj < 2; ++bj)
#pragma unroll
            for (int n = 0; n < 2; ++n) gv[bj][n] = *(const f32x4*)(gp + bj * 128 + n * 4);
#pragma unroll
        for (int ai = 0; ai < 2; ++ai) {
            f32x4 xv[4][2][2];
#pragma unroll
            for (int m = 0; m < 4; ++m) { const int row = row0 + ai * 128 + m * 16;
                const float* xr = (row < MCTX ? xp + (size_t)row * DM : xs + (size_t)(row - MCTX) * DM) + col0;
#pragma unroll
                for (int bj = 0; bj < 2; ++bj)
#pragma unroll
                    for (int n = 0; n < 2; ++n) xv[m][bj][n] = *(const f32x4*)(xr + bj * 128 + n * 4); }
#pragma unroll
            for (int m = 0; m < 4; ++m) { bf16_t* prow = pre + (size_t)(row0 + ai * 128 + m * 16) * DM + col0;
#pragma unroll
                for (int bj = 0; bj < 2; ++bj) { const f32x4 v0 = xv[m][bj][0] * ALPHA + gv[bj][0] * acc[ai][bj][m][0], v1 = xv[m][bj][1] * ALPHA + gv[bj][1] * acc[ai][bj][m][1];
                    u32x4 w; w.x = cvt_pk_bf16(v0[0], v0[1]); w.y = cvt_pk_bf16(v0[2], v0[3]); w.z = cvt_pk_bf16(v1[0], v1[1]); w.w = cvt_pk_bf16(v1[2], v1[3]);
                    *(u32x4*)(prow + bj * 128) = w; } }
            asm volatile("" ::: "memory");
        }
    }
};
struct EpiPre2 {
    static constexpr bool PERM = true, AFTER_DRAIN = false;
    const bf16_t* __restrict__ pre1; const float* __restrict__ stats; const float* __restrict__ g1; const float* __restrict__ b1; bf16_t* __restrict__ pre2; const float* __restrict__ gate; bf16_t* __restrict__ part;
    __device__ __forceinline__ void operator()(const f32x4 (&acc)[2][2][4][2], const Unit& u, int wr, int wc, int fr, int fq) const {
        int pn_l = u.pn; asm volatile("" : "+s"(pn_l));
        const int row0 = u.pm * 256 + wr * 64 + fr, col0 = pn_l * 256 + wc * 32 + 8 * fq;
        const int mrow = u.pm < 16 ? 4 : ((u.pm - 16) >> 4);
        const float* gp = gate + (size_t)mrow * NMOD + col0;
        f32x4 gv[2][2];
#pragma unroll
        for (int bj = 0; bj < 2; ++bj)
#pragma unroll
            for (int n = 0; n < 2; ++n) gv[bj][n] = *(const f32x4*)(gp + bj * 128 + n * 4);
        if (u.ks) {
#pragma unroll
            for (int ai = 0; ai < 2; ++ai)
#pragma unroll
                for (int m = 0; m < 4; ++m) { bf16_t* prow = part + (size_t)(row0 + ai * 128 + m * 16 - 16384) * DM + col0;
#pragma unroll
                    for (int bj = 0; bj < 2; ++bj) { const f32x4 v0 = gv[bj][0] * acc[ai][bj][m][0], v1 = gv[bj][1] * acc[ai][bj][m][1];
                        u32x4 w; w.x = cvt_pk_bf16(v0[0], v0[1]); w.y = cvt_pk_bf16(v0[2], v0[3]); w.z = cvt_pk_bf16(v1[0], v1[1]); w.w = cvt_pk_bf16(v1[2], v1[3]);
                        *(u32x4*)(prow + bj * 128) = w; } }
            return;
        }
        f32x4 lg[2][2], lb[2][2];
#pragma unroll
        for (int bj = 0; bj < 2; ++bj)
#pragma unroll
            for (int n = 0; n < 2; ++n) { lg[bj][n] = *(const f32x4*)(g1 + col0 + bj * 128 + n * 4); lb[bj][n] = *(const f32x4*)(b1 + col0 + bj * 128 + n * 4); }
#pragma unroll
        for (int ai = 0; ai < 2; ++ai) {
            u32x4 pv[4][2]; float2 st[4];
#pragma unroll
            for (int m = 0; m < 4; ++m) { const int row = row0 + ai * 128 + m * 16;
                st[m] = *(const float2*)(stats + (size_t)row * 2);
#pragma unroll
                for (int bj = 0; bj < 2; ++bj) pv[m][bj] = *(const u32x4*)(pre1 + (size_t)row * DM + col0 + bj * 128); }
#pragma unroll
            for (int m = 0; m < 4; ++m) { bf16_t* orow = pre2 + (size_t)(row0 + ai * 128 + m * 16) * DM + col0;
                const float mu = st[m].x, rs = st[m].y;
#pragma unroll
                for (int bj = 0; bj < 2; ++bj) { const u32x4 p = pv[m][bj];
                    const f32x4 p0 = {bf_lo(p.x), bf_hi(p.x), bf_lo(p.y), bf_hi(p.y)}, p1 = {bf_lo(p.z), bf_hi(p.z), bf_lo(p.w), bf_hi(p.w)};
                    const f32x4 x0 = (p0 - mu) * rs * lg[bj][0] + lb[bj][0], x1 = (p1 - mu) * rs * lg[bj][1] + lb[bj][1];
                    const f32x4 v0 = x0 * ALPHA + gv[bj][0] * acc[ai][bj][m][0], v1 = x1 * ALPHA + gv[bj][1] * acc[ai][bj][m][1];
                    u32x4 w; w.x = cvt_pk_bf16(v0[0], v0[1]); w.y = cvt_pk_bf16(v0[2], v0[3]); w.z = cvt_pk_bf16(v1[0], v1[1]); w.w = cvt_pk_bf16(v1[2], v1[3]);
                    *(u32x4*)(orow + bj * 128) = w; } }
            asm volatile("" ::: "memory");
        }
    }
};
struct SplitOrder {
    int c;
    __device__ __forceinline__ bool next(int i, Unit& u) const {
        const int xcd = c & 7, offc = c >> 3;
        const bool rem = (i == 2);
        const int pmv = 4 * xcd + (offc & 3);
        const int ks = pmv >> 4;
        u.pm = rem ? 64 + (pmv & 15) : 8 * xcd + 4 * i + (offc & 3);
        u.pn = offc >> 2;
        u.ks = rem ? ks : 0; u.kt0 = rem ? ks * (DFF / 128) : 0; u.nkt = rem ? (DFF / 128) : (DFF / 64);
        return i <= 2;
    }
    __device__ __forceinline__ void a_ready(const Unit&) const {}
    __device__ __forceinline__ void done(const Unit&) const {}
};

template <bool TILED = false> __device__ __forceinline__ void transpose_piece(const float* __restrict__ W, int Krows, int Ncols, bf16_t* __restrict__ WT, int kt, int nt, int lane) {
    const int nq = lane >> 3, kg = lane & 7;
    const float* src = W + (size_t)(kt * 64 + kg * 8) * Ncols + nt * 32 + nq * 4;
    f32x4 r[8];
#pragma unroll
    for (int i = 0; i < 8; ++i) r[i] = __builtin_nontemporal_load((const f32x4*)(src + (size_t)i * Ncols));
    const int n0 = nt * 32 + nq * 4;
    bf16_t* dst = TILED ? WT + ((((size_t)(n0 >> 8) * (Krows / 64) + kt) * 256 + (n0 & 255)) * 64 + kg * 8) : WT + (size_t)n0 * Krows + kt * 64 + kg * 8;
    const size_t jstep = TILED ? 64 : (size_t)Krows;
#pragma unroll
    for (int j = 0; j < 4; ++j) { u32x4 w; w.x = cvt_pk_bf16(r[0][j], r[1][j]); w.y = cvt_pk_bf16(r[2][j], r[3][j]); w.z = cvt_pk_bf16(r[4][j], r[5][j]); w.w = cvt_pk_bf16(r[6][j], r[7][j]);
        *(u32x4*)(dst + (size_t)j * jstep) = w; }
}
constexpr int T_WIN = 32 * 80, T_WOUT = 32 * 64, T_FF1 = 32 * 256, T_FF2 = 128 * 64;
__device__ __forceinline__ void transpose_item(const Args& a, int it, int lane) {
    unsigned char* ws = a.ws;
    if (it < T_WIN) { transpose_piece(a.in[I_WIN], DM, NIN, (bf16_t*)(ws + WS_WIN), it / 80, it % 80, lane); return; }
    it -= T_WIN;
    if (it < T_WOUT) { transpose_piece(a.in[I_WOUT], DM, DM, (bf16_t*)(ws + WS_WOUT), it / 64, it % 64, lane); return; }
    it -= T_WOUT;
    if (it < T_FF1) { transpose_piece(a.in[I_WFF1], DM, DFF, (bf16_t*)(ws + WS_WFF1), it / 256, it % 256, lane); return; }
    it -= T_FF1;
    if (it < T_FF2) { transpose_piece<true>(a.in[I_WFF2], DFF, DM, (bf16_t*)(ws + WS_WFF2), it / 64, it % 64, lane); return; }
    it -= T_FF2;
    { const int g = it >> 5, tt = it & 31; transpose_piece(a.in[I_WPOOL] + (size_t)g * 65536, 256, 256, (bf16_t*)(ws + WS_WPOOL) + (size_t)g * 65536, tt >> 3, tt & 7, lane); }
}
constexpr int N_TITEMS = 32 * 80 + 32 * 64 + 32 * 256 + 128 * 64 + 128;
__device__ __forceinline__ void mod_job(const Args& a, int job, float* __restrict__ mod, float* lds) {
    float* sil = lds; float* red = lds + 5 * DM;
    const int t = threadIdx.x;
    for (int i = t; i < 5 * DM; i += 512) { const float x = (i < 4 * DM) ? a.in[I_C][i] : a.in[I_CCTX][i - 4 * DM]; sil[i] = x / (1.f + __expf(-x)); }
    __syncthreads();
    const int cg4 = t & 15, ch = t >> 4, col0 = job * 64 + cg4 * 4;
    f32x4 a0 = {0.f, 0.f, 0.f, 0.f}, a1 = a0, a2 = a0, a3 = a0, a4 = a0;
    const float* wp = a.in[I_WMOD] + (size_t)(ch * 64) * NMOD + col0;
#pragma unroll 16
    for (int i = 0; i < 64; ++i) { const f32x4 w = __builtin_nontemporal_load((const f32x4*)(wp + (size_t)i * NMOD)); const int d = ch * 64 + i;
        a0 += w * sil[d]; a1 += w * sil[DM + d]; a2 += w * sil[2 * DM + d]; a3 += w * sil[3 * DM + d]; a4 += w * sil[4 * DM + d]; }
    *(f32x4*)(red + (ch * 5 + 0) * 64 + cg4 * 4) = a0; *(f32x4*)(red + (ch * 5 + 1) * 64 + cg4 * 4) = a1; *(f32x4*)(red + (ch * 5 + 2) * 64 + cg4 * 4) = a2;
    *(f32x4*)(red + (ch * 5 + 3) * 64 + cg4 * 4) = a3; *(f32x4*)(red + (ch * 5 + 4) * 64 + cg4 * 4) = a4;
    __syncthreads();
    if (t < 320) { const int r = t >> 6, col = t & 63; float s = 0.f;
#pragma unroll 8
        for (int c = 0; c < 32; ++c) s += red[(c * 5 + r) * 64 + col];
        mod[(size_t)r * NMOD + job * 64 + col] = s + a.in[I_BMOD][job * 64 + col]; }
    __syncthreads();
}
__device__ __forceinline__ void slack_transposes(const Args& a, int lo, int hi, int first_wg) {
    int tid_l = threadIdx.x; asm volatile("" : "+v"(tid_l));
    const int lane = tid_l & 63, wid = tid_l >> 6, bid = blockIdx.x;
    if (bid < first_wg) return;
    for (int it = lo + (bid - first_wg) * 8 + wid; it < hi; it += (256 - first_wg) * 8) transpose_item(a, it, lane);
}
__device__ void phase_prep(const Args& a, float* lds) {
    unsigned char* ws = a.ws;
    float* mod = (float*)(ws + WS_MOD);
    int tid_l = threadIdx.x; asm volatile("" : "+v"(tid_l));
    const int lane = tid_l & 63, wid = tid_l >> 6, G = gridDim.x, bid = blockIdx.x;
    constexpr int J_MOD = NMOD / 64;
    if (G == 256) {
        if (bid < J_MOD) mod_job(a, bid, mod, lds);
        else { for (int it = (bid - J_MOD) * 8 + wid; it < T_WIN; it += 64 * 8) transpose_item(a, it, lane);
               for (int it = N_TITEMS - 128 + (bid - J_MOD) * 8 + wid; it < N_TITEMS; it += 64 * 8) transpose_item(a, it, lane); }
    } else {
        for (int job = bid; job < J_MOD; job += G) mod_job(a, job, mod, lds);
        for (int it = bid * 8 + wid; it < N_TITEMS; it += G * 8) transpose_item(a, it, lane);
    }
    bf16_t* klat = (bf16_t*)(ws + WS_KLAT); bf16_t* vlat = (bf16_t*)(ws + WS_VLAT);
    constexpr int NC8 = 4 * 512 * 256 / 8;
    for (int i = bid * 512 + tid_l; i < 2 * NC8; i += G * 512) {
        const bool isk = i < NC8; const int e = (isk ? i : i - NC8) * 8;
        const float* src = (isk ? a.in[I_CK] : a.in[I_CV]) + e;
        const f32x4 v0 = *(const f32x4*)src, v1 = *(const f32x4*)(src + 4);
        const int b = e / (512 * 256), rem = e % (512 * 256);
        bf16_t* dst = (isk ? klat : vlat) + (size_t)b * SKV_LAT * 256 + rem;
        u32x4 w; w.x = cvt_pk_bf16(v0[0], v0[1]); w.y = cvt_pk_bf16(v0[2], v0[3]); w.z = cvt_pk_bf16(v1[0], v1[1]); w.w = cvt_pk_bf16(v1[2], v1[3]);
        *(u32x4*)dst = w;
    }
    float* ropeC = (float*)(ws + WS_ROPE); float* ropeS = ropeC + 2048;
    for (int i = bid * 512 + tid_l; i < 2048; i += G * 512) { const int pos = i >> 5, fi = i & 31;
        const float inv = exp2f(-(float)fi * (13.287712379549449f / 32.f)); const float ang = (float)pos * inv;
        ropeC[i] = cosf(ang); ropeS[i] = sinf(ang); }
}

__device__ __forceinline__ void row_stats(const f32x4 (&v)[8], float& mu, float& rstd) {
    float s = 0.f;
#pragma unroll
    for (int i = 0; i < 8; ++i) s += (v[i][0] + v[i][1]) + (v[i][2] + v[i][3]);
    s = wave_sum(s); mu = s * (1.f / DM);
    float q = 0.f;
#pragma unroll
    for (int i = 0; i < 8; ++i) { const f32x4 d = v[i] - mu; q += (d[0] * d[0] + d[1] * d[1]) + (d[2] * d[2] + d[3] * d[3]); }
    q = wave_sum(q); rstd = 1.0f / sqrtf(q * (1.f / DM) + LN_EPS);
}
#define LD8(dst, p) do { _Pragma("unroll") for (int _i = 0; _i < 8; ++_i) dst[_i] = *(const f32x4*)((p) + _i * 256 + lane * 4); } while (0)
__device__ __forceinline__ void ln_in_row(const f32x4 (&v)[8], const f32x4 (&sh)[8], const f32x4 (&sc)[8], bf16_t* __restrict__ urow, int lane) {
    float mu, rstd; row_stats(v, mu, rstd);
#pragma unroll
    for (int i = 0; i < 8; ++i) { const int col = i * 256 + lane * 4;
        const f32x4 o = (v[i] - mu) * rstd * (sc[i] + 1.0f) + sh[i];
        u32x2 w; w.x = cvt_pk_bf16(o[0], o[1]); w.y = cvt_pk_bf16(o[2], o[3]);
        *(u32x2*)(urow + col) = w; }
}
__device__ void phase_ln_in(const Args& a) {
    int tid_l = threadIdx.x; asm volatile("" : "+v"(tid_l));
    const int lane = tid_l & 63, wid = tid_l >> 6;
    const float* __restrict__ mod = (const float*)(a.ws + WS_MOD); bf16_t* __restrict__ U = (bf16_t*)(a.ws + WS_ACT);
    const int stride = gridDim.x * 8; int row = blockIdx.x * 8 + wid;
    f32x4 nx0[8], nx1[8];
    if (row < MTOT) { LD8(nx0, x_row(a, row)); LD8(nx1, x_row(a, min(row + stride, MTOT - 1))); }
    for (; row < MTOT; row += 2 * stride) {
        const int row1 = row + stride;
        f32x4 v0[8], v1[8], sh[8], sc[8];
        const int mr0 = mod_row_of(row);
        { const float* mp = mod + (size_t)mr0 * NMOD; LD8(sh, mp); LD8(sc, mp + DM); }
#pragma unroll
        for (int i = 0; i < 8; ++i) { v0[i] = nx0[i]; v1[i] = nx1[i]; }
        LD8(nx0, x_row(a, min(row + 2 * stride, MTOT - 1))); LD8(nx1, x_row(a, min(row + 3 * stride, MTOT - 1)));
        ln_in_row(v0, sh, sc, U + (size_t)row * DM, lane);
        if (row1 < MTOT) {
            const int mr1 = mod_row_of(row1);
            if (mr1 != mr0) { const float* mp = mod + (size_t)mr1 * NMOD; LD8(sh, mp); LD8(sc, mp + DM); }
            ln_in_row(v1, sh, sc, U + (size_t)row1 * DM, lane);
        }
    }
}
__device__ __forceinline__ void ld_row_bf16(const bf16_t* __restrict__ p, int lane, u32x4 (&w)[4]) {
#pragma unroll
    for (int i = 0; i < 4; ++i) w[i] = *(const u32x4*)(p + i * 512 + lane * 8);
}
__device__ __forceinline__ void unpack_row(const u32x4 (&w)[4], float (&v)[32]) {
#pragma unroll
    for (int i = 0; i < 4; ++i) { v[8 * i + 0] = bf_lo(w[i].x); v[8 * i + 1] = bf_hi(w[i].x); v[8 * i + 2] = bf_lo(w[i].y); v[8 * i + 3] = bf_hi(w[i].y);
        v[8 * i + 4] = bf_lo(w[i].z); v[8 * i + 5] = bf_hi(w[i].z); v[8 * i + 6] = bf_lo(w[i].w); v[8 * i + 7] = bf_hi(w[i].w); }
}
__device__ __forceinline__ void ld_vec32(const float* __restrict__ p, int lane, float (&g)[32]) {
#pragma unroll
    for (int i = 0; i < 4; ++i) { const f32x4 a = *(const f32x4*)(p + i * 512 + lane * 8), b = *(const f32x4*)(p + i * 512 + lane * 8 + 4);
#pragma unroll
        for (int e = 0; e < 4; ++e) { g[8 * i + e] = a[e]; g[8 * i + 4 + e] = b[e]; } }
}
__device__ __forceinline__ void stats32(const float (&v)[32], float& mu, float& rstd) {
    float s = 0.f;
#pragma unroll
    for (int i = 0; i < 32; ++i) s += v[i];
    s = wave_sum(s); mu = s * (1.f / DM);
    float q = 0.f;
#pragma unroll
    for (int i = 0; i < 32; ++i) { const float d = v[i] - mu; q += d * d; }
    q = wave_sum(q); rstd = 1.0f / sqrtf(q * (1.f / DM) + LN_EPS);
}
__device__ __forceinline__ void ln_mid_row(const u32x4 (&raw)[4], const float (&g)[32], const float (&b)[32], const float (&sh)[32], const float (&sc)[32], float* __restrict__ st, bf16_t* __restrict__ urow, int lane) {
    float v[32]; unpack_row(raw, v);
    float mu, rstd; stats32(v, mu, rstd);
    if (lane == 0) { float2 s2; s2.x = mu; s2.y = rstd; *(float2*)st = s2; }
#pragma unroll
    for (int i = 0; i < 32; ++i) v[i] = (v[i] - mu) * rstd * g[i] + b[i];
    float mu2, rstd2; stats32(v, mu2, rstd2);
#pragma unroll
    for (int i = 0; i < 4; ++i) { float o[8];
#pragma unroll
        for (int e = 0; e < 8; ++e) o[e] = (v[8 * i + e] - mu2) * rstd2 * (sc[8 * i + e] + 1.0f) + sh[8 * i + e];
        u32x4 w; w.x = cvt_pk_bf16(o[0], o[1]); w.y = cvt_pk_bf16(o[2], o[3]); w.z = cvt_pk_bf16(o[4], o[5]); w.w = cvt_pk_bf16(o[6], o[7]);
        *(u32x4*)(urow + i * 512 + lane * 8) = w; }
}
__device__ void phase_ln_mid(const Args& a) {
    int tid_l = threadIdx.x; asm volatile("" : "+v"(tid_l));
    const int lane = tid_l & 63, wid = tid_l >> 6;
    const float* __restrict__ mod = (const float*)(a.ws + WS_MOD); bf16_t* __restrict__ U = (bf16_t*)(a.ws + WS_ACT);
    const bf16_t* __restrict__ pre1 = (const bf16_t*)a.out; float* __restrict__ stats = (float*)(a.ws + WS_STATS);
    const int stride = gridDim.x * 8; int row = blockIdx.x * 8 + wid;
    float g[32], b[32]; ld_vec32(a.in[I_LN1G], lane, g); ld_vec32(a.in[I_LN1B], lane, b);
    u32x4 nx0[4], nx1[4];
    if (row < MTOT) { ld_row_bf16(pre1 + (size_t)row * DM, lane, nx0); ld_row_bf16(pre1 + (size_t)min(row + stride, MTOT - 1) * DM, lane, nx1); }
    for (; row < MTOT; row += 2 * stride) {
        const int row1 = row + stride;
        float sh[32], sc[32];
        const int mr0 = mod_row_of(row);
        { const float* mp = mod + (size_t)mr0 * NMOD + 3 * DM; ld_vec32(mp, lane, sh); ld_vec32(mp + DM, lane, sc); }
        u32x4 c0[4], c1[4];
#pragma unroll
        for (int i = 0; i < 4; ++i) { c0[i] = nx0[i]; c1[i] = nx1[i]; }
        ld_row_bf16(pre1 + (size_t)min(row + 2 * stride, MTOT - 1) * DM, lane, nx0); ld_row_bf16(pre1 + (size_t)min(row + 3 * stride, MTOT - 1) * DM, lane, nx1);
        ln_mid_row(c0, g, b, sh, sc, stats + (size_t)row * 2, U + (size_t)row * DM, lane);
        if (row1 < MTOT) {
            const int mr1 = mod_row_of(row1);
            if (mr1 != mr0) { const float* mp = mod + (size_t)mr1 * NMOD + 3 * DM; ld_vec32(mp, lane, sh); ld_vec32(mp + DM, lane, sc); }
            ln_mid_row(c1, g, b, sh, sc, stats + (size_t)row1 * 2, U + (size_t)row1 * DM, lane);
        }
    }
}
__device__ __forceinline__ void ln_out_row(const u32x4 (&raw)[4], const u32x4 (&praw)[4], bool has_part, const float (&g)[32], const float (&b)[32], float* __restrict__ orow, int lane) {
    float v[32]; unpack_row(raw, v);
    if (has_part) { float pp[32]; unpack_row(praw, pp);
#pragma unroll
        for (int i = 0; i < 32; ++i) v[i] += pp[i]; }
    float mu, rstd; stats32(v, mu, rstd);
#pragma unroll
    for (int i = 0; i < 4; ++i) { f32x4 o0, o1;
#pragma unroll
        for (int e = 0; e < 4; ++e) { o0[e] = (v[8 * i + e] - mu) * rstd * g[8 * i + e] + b[8 * i + e]; o1[e] = (v[8 * i + 4 + e] - mu) * rstd * g[8 * i + 4 + e] + b[8 * i + 4 + e]; }
        float* op = orow + i * 512 + lane * 8;
        *(f32x4*)op = o0; *(f32x4*)(op + 4) = o1; }
}
__device__ void phase_ln_out(const Args& a, const bf16_t* __restrict__ pre2, const bf16_t* __restrict__ part) {
    int tid_l = threadIdx.x; asm volatile("" : "+v"(tid_l));
    const int lane = tid_l & 63, wid = tid_l >> 6;
    float* __restrict__ out = a.out;
    const int stride = gridDim.x * 8; int row = blockIdx.x * 8 + wid;
    float g[32], b[32]; ld_vec32(a.in[I_LN2G], lane, g); ld_vec32(a.in[I_LN2B], lane, b);
    u32x4 nx0[4], nx1[4], np0[4], np1[4];
#pragma unroll
    for (int i = 0; i < 4; ++i) { np0[i] = (u32x4){0u, 0u, 0u, 0u}; np1[i] = np0[i]; }
#define LDROWP(nx, np, r) do { const int r_ = min((r), MTOT - 1); ld_row_bf16(pre2 + (size_t)r_ * DM, lane, nx); if (part && r_ >= 16384) ld_row_bf16(part + (size_t)(r_ - 16384) * DM, lane, np); } while (0)
    if (row < MTOT) { LDROWP(nx0, np0, row); LDROWP(nx1, np1, row + stride); }
    for (; row < MTOT; row += 2 * stride) {
        const int row1 = row + stride;
        u32x4 c0[4], c1[4], p0[4], p1[4];
#pragma unroll
        for (int i = 0; i < 4; ++i) { c0[i] = nx0[i]; c1[i] = nx1[i]; p0[i] = np0[i]; p1[i] = np1[i]; }
        LDROWP(nx0, np0, row + 2 * stride); LDROWP(nx1, np1, row + 3 * stride);
        ln_out_row(c0, p0, part && row >= 16384, g, b, out + (size_t)row * DM, lane);
        if (row1 < MTOT) ln_out_row(c1, p1, part && row1 >= 16384, g, b, out + (size_t)row1 * DM, lane);
    }
#undef LDROWP
}

__device__ __forceinline__ float row16_sum(float v) { v += dpp_f<0xB1>(v); v += dpp_f<0x4E>(v); v += dpp_f<0x141>(v); v += dpp_f<0x140>(v); return v; }
__device__ __forceinline__ float lane_xor4(float v) { return dpp_f<0x1B>(dpp_f<0x141>(v)); }
__device__ __forceinline__ void unpack8(const u32x4 w, float (&x)[8]) { x[0] = bf_lo(w.x); x[1] = bf_hi(w.x); x[2] = bf_lo(w.y); x[3] = bf_hi(w.y); x[4] = bf_lo(w.z); x[5] = bf_hi(w.z); x[6] = bf_lo(w.w); x[7] = bf_hi(w.w); }
__device__ __forceinline__ u32x4 pack8(const float (&x)[8]) { u32x4 w; w.x = cvt_pk_bf16(x[0], x[1]); w.y = cvt_pk_bf16(x[2], x[3]); w.z = cvt_pk_bf16(x[4], x[5]); w.w = cvt_pk_bf16(x[6], x[7]); return w; }
__device__ __forceinline__ void norm_rope8(float (&x)[8], const float (&gn)[8], const float (&cs)[8], const float (&sn)[8], bool lat) {
    float ss = 0.f;
#pragma unroll
    for (int e = 0; e < 8; ++e) ss += x[e] * x[e];
    ss = row16_sum(ss); const float rinv = 1.0f / sqrtf(ss * (1.f / 128.f) + LN_EPS);
#pragma unroll
    for (int e = 0; e < 8; ++e) x[e] = x[e] * rinv * gn[e];
    if (lat) {
#pragma unroll
        for (int e = 0; e < 8; ++e) { const float p = lane_xor4(x[e]); x[e] = x[e] * cs[e] + p * sn[e]; } }
}
__device__ void phase_elem(const Args& a) {
    int tid_l = threadIdx.x; asm volatile("" : "+v"(tid_l));
    const int lane = tid_l & 63, wid = tid_l >> 6;
    unsigned char* ws = a.ws;
    const bf16_t* __restrict__ PROJ = (const bf16_t*)(ws + WS_PROJ);
    bf16_t* __restrict__ KL = (bf16_t*)(ws + WS_KLAT); bf16_t* __restrict__ VL = (bf16_t*)(ws + WS_VLAT);
    bf16_t* __restrict__ KC = (bf16_t*)(ws + WS_KCTX); bf16_t* __restrict__ VC = (bf16_t*)(ws + WS_VCTX);
    const float* __restrict__ ropeC = (const float*)(ws + WS_ROPE); const float* __restrict__ ropeS = ropeC + 2048;
    float* __restrict__ ctxk = a.out + (size_t)MTOT * DM; float* __restrict__ ctxv = ctxk + (size_t)MCTX * 256;
    const int j16 = lane & 15; const bool colpart = j16 >= 8, second = (j16 & 4) != 0; const int f0 = 8 * (j16 & 3);
    float kg[8];
#pragma unroll
    for (int e = 0; e < 8; ++e) kg[e] = a.in[I_KG][8 * j16 + e];
    const int stride = gridDim.x * 8;
    for (int base = blockIdx.x * 8 + wid; base < MTOT; base += 5 * stride) {
        u32x4 c2[5]; f32x4 ca[5], cb[5], sa[5], sb[5];
#pragma unroll
        for (int k = 0; k < 5; ++k) { const int tk = min(base + k * stride, MTOT - 1);
            c2[k] = *(const u32x4*)(PROJ + (size_t)tk * NIN + 1024 + lane * 8);
            const bool latk = tk >= MCTX; const int sk = (tk - MCTX) & 4095;
            const int pos = latk ? (colpart ? (sk & 63) : (sk >> 6)) : 0;
            ca[k] = *(const f32x4*)(ropeC + pos * 32 + f0); cb[k] = *(const f32x4*)(ropeC + pos * 32 + f0 + 4); sa[k] = *(const f32x4*)(ropeS + pos * 32 + f0); sb[k] = *(const f32x4*)(ropeS + pos * 32 + f0 + 4); }
#pragma unroll
        for (int k = 0; k < 5; ++k) { const int tok = base + k * stride;
            if (tok < MTOT) {
                const bool lat = tok >= MCTX;
                int b, s; if (!lat) { b = tok >> 8; s = tok & 255; } else { const int tt = tok - MCTX; b = tt >> 12; s = tt & 4095; }
                float cs[8], sn[8];
#pragma unroll
                for (int e = 0; e < 4; ++e) { cs[e] = ca[k][e]; cs[4 + e] = cb[k][e]; sn[e] = second ? sa[k][e] : -sa[k][e]; sn[4 + e] = second ? sb[k][e] : -sb[k][e]; }
                float x2[8]; unpack8(c2[k], x2);
                float x2n[8];
#pragma unroll
                for (int e = 0; e < 8; ++e) x2n[e] = x2[e];
                norm_rope8(x2n, kg, cs, sn, lat);
                const bool isk = lane < 32;
                float kv[8];
#pragma unroll
                for (int e = 0; e < 8; ++e) kv[e] = isk ? x2n[e] : x2[e];
                const u32x4 kvw = pack8(kv);
                const int off = (lane & 31) * 8;
                if (lat) { bf16_t* dst = (isk ? KL : VL) + ((size_t)b * SKV_LAT + 512 + s) * 256 + off; *(u32x4*)dst = kvw; }
                else { bf16_t* dst = (isk ? KC : VC) + (size_t)tok * 256 + off; *(u32x4*)dst = kvw;
                    float* fo = (isk ? ctxk : ctxv) + (size_t)tok * 256 + off;
                    *(f32x4*)fo = (f32x4){kv[0], kv[1], kv[2], kv[3]}; *(f32x4*)(fo + 4) = (f32x4){kv[4], kv[5], kv[6], kv[7]}; }
            } }
    }
}
__device__ __forceinline__ void add8(float (&acc)[8], const u32x4 w, float wgt) {
    acc[0] += wgt * bf_lo(w.x); acc[1] += wgt * bf_hi(w.x); acc[2] += wgt * bf_lo(w.y); acc[3] += wgt * bf_hi(w.y);
    acc[4] += wgt * bf_lo(w.z); acc[5] += wgt * bf_hi(w.z); acc[6] += wgt * bf_lo(w.w); acc[7] += wgt * bf_hi(w.w);
}
__device__ __forceinline__ void seq_bounds(int t, int& sb, int& se) { if (t < MCTX) { sb = t & ~255; se = sb + 256; } else { sb = MCTX + ((t - MCTX) & ~4095); se = sb + 4096; } }
__device__ __forceinline__ void window_init(const bf16_t* __restrict__ pb, int cur, int half, float (&acc)[8]) {
    int sb, se; seq_bounds(cur, sb, se);
#pragma unroll
    for (int e = 0; e < 8; ++e) acc[e] = 0.f;
    for (int i = 0; i < 2 * half; ++i) { const int r = cur - half + i; const float wgt = (r >= sb && r < se) ? 1.f : 0.f; const int rc = min(max(r, sb), se - 1);
        add8(acc, *(const u32x4*)(pb + (size_t)rc * NIN), wgt); }
}
__device__ void phase_pooled(const Args& a) {
    int tid_l = threadIdx.x; asm volatile("" : "+v"(tid_l));
    const bf16_t* __restrict__ PROJ = (const bf16_t*)(a.ws + WS_PROJ); bf16_t* __restrict__ PO = (bf16_t*)(a.ws + WS_POOLED);
    constexpr int RUN = 20, NITEM = (MTOT / RUN) * 128;
    for (int item = blockIdx.x * 512 + tid_l; item < NITEM; item += gridDim.x * 512) {
        const int run = item >> 7, oct = item & 127, half = 1 << (oct >> 5);
        const int r0 = run * RUN;
        const bf16_t* pb = PROJ + 1536 + 8 * oct;
        bf16_t* ob = PO + 8 * oct;
        float acc[8];
        window_init(pb, r0, half, acc);
#pragma unroll 4
        for (int j = 0; j < RUN; ++j) {
            const int cur = r0 + j;
            int sb, se; seq_bounds(cur, sb, se);
            const int lo = max(cur - half, sb), hi = min(cur + half, se);
            const u32x4 self = *(const u32x4*)(pb + (size_t)cur * NIN);
            const int rin = cur + half, rout = cur - half;
            const u32x4 win = *(const u32x4*)(pb + (size_t)min(rin, se - 1) * NIN), wout = *(const u32x4*)(pb + (size_t)max(rout, sb) * NIN);
            const float ic = 1.0f / (float)(hi - lo);
            float sv[8]; unpack8(self, sv);
            float o[8];
#pragma unroll
            for (int e = 0; e < 8; ++e) o[e] = acc[e] * ic - sv[e];
            *(u32x4*)(ob + (size_t)cur * 1024) = pack8(o);
            if (cur + 1 < se) { add8(acc, win, rin < se ? 1.f : 0.f); add8(acc, wout, rout >= sb ? -1.f : 0.f); }
            else if (j + 1 < RUN) window_init(pb, cur + 1, half, acc);
        }
    }
}

typedef const Args __attribute__((address_space(4)))* KArgsP;
__device__ __forceinline__ Args load_args() {
    Args r;
#if defined(__HIP_DEVICE_COMPILE__)
    KArgsP p = (KArgsP)__builtin_amdgcn_kernarg_segment_ptr(); asm volatile("" : "+s"(p));
#pragma unroll
    for (int i = 0; i < 20; ++i) r.in[i] = p->in[i];
    r.out = p->out; r.ws = p->ws;
#endif
    return r;
}
#define SEAM() do { XcdBarrier xb_; { unsigned* bp_ = (unsigned*)(load_args().ws + WS_BAR); asm volatile("" : "+s"(bp_)); xb_.bar = bp_; } xb_.x = xb_xcc_id(); \
    xb_.st = (volatile LAS unsigned*)((PG8_LAS unsigned char*)shm + 131072); xcd_barrier(xb_); } while (0)
#ifndef REP_P0
#define REP_P0 1
#endif
#ifndef REP_P3B
#define REP_P3B 1
#endif
#ifndef REP_P6
#define REP_P6 1
#endif
__global__ void __launch_bounds__(512, 2) mega_fwd(Args a_unused) {
    extern __shared__ __attribute__((aligned(16))) unsigned char shm[];
    PG8_LAS unsigned char* lds3 = (PG8_LAS unsigned char*)shm;
    const int G = gridDim.x, bid = blockIdx.x;

    { const Args a = load_args();
      unsigned* barw = (unsigned*)(a.ws + WS_BAR);
      volatile LAS unsigned* bst = (volatile LAS unsigned*)(lds3 + 131072);
      if (bid == 0) for (int i = threadIdx.x; i < XCD_BAR_WORDS; i += 512) barw[i] = 0u;
      if (threadIdx.x == 0) { bst[0] = 0u; bst[1] = 0u; }
      for (int rep = 0; rep < REP_P0; ++rep) phase_prep(a, (float*)shm);
      cg::this_grid().sync();
      (void)xcd_barrier_post(barw, bst); }
    { const Args a = load_args(); phase_ln_in(a); }
    SEAM();
    { const Args a = load_args(); unsigned char* ws = a.ws;
      pg8::Gemm g{(const bf16_t*)(ws + WS_ACT), (const bf16_t*)(ws + WS_WIN), MTOT, NIN, DM, DM, DM, 0, 0, 0, 0, 0}; pg8::StaticOrder S; S.init(MTOT, NIN, G, bid);
      EpiB<0, false> E{(bf16_t*)(ws + WS_PROJ), NIN, nullptr};
      pg8::gemm_phase<EpiB<0, false>, pg8::StaticOrder>(lds3, g, S, E, nullptr);
      if (G == 256) slack_transposes(a, T_WIN, T_WIN + T_WOUT + T_FF1 + T_FF2 / 2, 32); }
    SEAM();
    { const Args a = load_args(); phase_elem(a); phase_pooled(a); }
    SEAM();
    for (int rep = 0; rep < REP_P3B; ++rep) {
        const Args a = load_args(); unsigned char* ws = a.ws;
        const att::bf16* Qb = (const att::bf16*)(ws + WS_PROJ); bf16_t* ACT = (bf16_t*)(ws + WS_ACT);
        for (int u = bid; u < 640; u += G) {
            const bool lat = u < 512; const int uu = lat ? u : u - 512;
            const int h = lat ? ((uu >> 4) & 7) : (uu & 7), b = lat ? (uu >> 7) : (uu >> 3);
            const size_t tok0 = lat ? ((size_t)MCTX + (size_t)b * 4096 + (uu & 15) * 256) : (size_t)b * 256;
            const size_t kvoff = (lat ? (size_t)b * SKV_LAT * 256 : tok0 * 256) + (h >> 2) * 128;
            const att::bf16* Kh = (const att::bf16*)(ws + (lat ? WS_KLAT : WS_KCTX)) + kvoff;
            const att::bf16* Vh = (const att::bf16*)(ws + (lat ? WS_VLAT : WS_VCTX)) + kvoff;
            __syncthreads();
            att::attn_dense_body<att::bf16>(Qb + tok0 * NIN + h * 128, Kh, Vh, ACT + tok0 * DM + h * 128, lat ? SKV_LAT : 256, (char*)shm,
                                            a.in[I_QG], (const float*)(ws + WS_ROPE), (const float*)(ws + WS_ROPE) + 2048, lat ? (uu & 15) * 256 : 0, lat);
        }
        __syncthreads();
        pg8::Gemm g{(const bf16_t*)(ws + WS_POOLED), (const bf16_t*)(ws + WS_WPOOL), MTOT, 1024, 256, 1024, 256, 512, 0, 0, 0, 0}; pg8::StaticOrder S; S.init(MTOT, 1024, G, (bid + G / 2) % G);
        EpiB<0, true> E{ACT + 1024, DM, a.in[I_PSCALE]};
        pg8::gemm_phase<EpiB<0, true>, pg8::StaticOrder>(lds3, g, S, E, nullptr);
    }
    SEAM();
    { const Args a = load_args(); unsigned char* ws = a.ws;
      pg8::Gemm g{(const bf16_t*)(ws + WS_ACT), (const bf16_t*)(ws + WS_WOUT), MTOT, DM, DM, DM, DM, 0, 0, 0, 0, 0}; pg8::StaticOrder S; S.init(MTOT, DM, G, bid);
      EpiPre1 E{a.in[I_XP], a.in[I_XS], (bf16_t*)a.out, (const float*)(ws + WS_MOD) + 2 * DM};
      pg8::gemm_phase<EpiPre1, pg8::StaticOrder>(lds3, g, S, E, nullptr);
      if (G == 256) slack_transposes(a, T_WIN + T_WOUT + T_FF1 + T_FF2 / 2, T_WIN + T_WOUT + T_FF1 + T_FF2, 128); }
    SEAM();
    { const Args a = load_args(); phase_ln_mid(a); }
    SEAM();
    for (int rep = 0; rep < REP_P6; ++rep) { const Args a = load_args(); unsigned char* ws = a.ws;
      pg8::Gemm g{(const bf16_t*)(ws + WS_ACT), (const bf16_t*)(ws + WS_WFF1), MTOT, DFF, DM, DM, DM, 0, 0, 0, 0, 0}; pg8::StaticOrder S; S.init(MTOT, DFF, G, bid);
      EpiB<1, false> E{(bf16_t*)(ws + WS_H), DFF, nullptr};
      pg8::gemm_phase<EpiB<1, false>, pg8::StaticOrder>(lds3, g, S, E, nullptr); }
    SEAM();
    { const Args a = load_args(); unsigned char* ws = a.ws;
      pg8::Gemm g{(const bf16_t*)(ws + WS_H), (const bf16_t*)(ws + WS_WFF2), MTOT, DM, DFF, 64, 64, 0, 256 * 64 * 2, 256 * 64 * 2, (DFF / 64) * 256 * 64 * 2, (DFF / 64) * 256 * 64 * 2};
      EpiPre2 E{(const bf16_t*)a.out, (const float*)(ws + WS_STATS), a.in[I_LN1G], a.in[I_LN1B], (bf16_t*)(ws + WS_ACT), (const float*)(ws + WS_MOD) + 5 * DM, (bf16_t*)(ws + WS_PART)};
      if (G == 256) { SplitOrder S; S.c = bid; pg8::gemm_phase<EpiPre2, SplitOrder>(lds3, g, S, E, nullptr); }
      else { pg8::StaticOrder S; S.init(MTOT, DM, G, bid); pg8::gemm_phase<EpiPre2, pg8::StaticOrder>(lds3, g, S, E, nullptr); } }
    SEAM();
    { const Args a = load_args(); phase_ln_out(a, (const bf16_t*)(a.ws + WS_ACT), G == 256 ? (const bf16_t*)(a.ws + WS_PART) : nullptr); }
}

extern "C" void kernel_launch(void* const* d_in, const int* in_sizes, int n_in, void* d_out, int out_size, void* d_ws, size_t ws_size, hipStream_t stream) {
    static int grid = 0;
    if (grid == 0) {
        if (n_in != 20 || ws_size < WS_END) { fprintf(stderr, "kernel_launch: need 20 inputs and %zu bytes of workspace (got %d, %zu)\n", (size_t)WS_END, n_in, ws_size); grid = -1; return; }
        int dev = 0, cus = 0, per_cu = 0;
        hipGetDevice(&dev); hipDeviceGetAttribute(&cus, hipDeviceAttributeMultiprocessorCount, dev);
        if (hipFuncSetAttribute((const void*)mega_fwd, hipFuncAttributeMaxDynamicSharedMemorySize, LDS_BYTES) != hipSuccess) { fprintf(stderr, "kernel_launch: hipFuncSetAttribute failed\n"); grid = -1; return; }
        if (hipOccupancyMaxActiveBlocksPerMultiprocessor(&per_cu, (const void*)mega_fwd, 512, LDS_BYTES) != hipSuccess || per_cu < 1) { fprintf(stderr, "kernel_launch: occupancy query says %d\n", per_cu); per_cu = 1; }
        (void)hipGetLastError();
        grid = cus * 1;
    }
    if (grid < 0) return;
    Args a{};
    for (int i = 0; i < 20; ++i) a.in[i] = (const float*)d_in[i];
    a.out = (float*)d_out; a.ws = (unsigned char*)d_ws;
    void* args[] = {&a};
    hipError_t e = hipLaunchCooperativeKernel((const void*)mega_fwd, dim3(grid), dim3(512), args, LDS_BYTES, stream);
    if (e != hipSuccess) fprintf(stderr, "kernel_launch: cooperative launch failed: %s (grid %d)\n", hipGetErrorString(e), grid);
}
```

```cpp
#include <hip/hip_runtime.h>
#include <hip/hip_bf16.h>
#include <hip/hip_cooperative_groups.h>
#include <cstdio>
#include <cstdint>
namespace cg = cooperative_groups;

constexpr int DM = 2048, MCTX = 4096, MLAT = 16384, MTOT = 20480, NIN = 2560, DFF = 8192, SKV_LAT = 4608, NMOD = 12288;
constexpr float LN_EPS = 1e-6f, ALPHA = 1.189207115002721f;
constexpr size_t al256(size_t x) { return (x + 255) / 256 * 256; }
constexpr size_t WS_WIN = 0;
constexpr size_t WS_WOUT = WS_WIN + (size_t)NIN * DM * 2;
constexpr size_t WS_WFF1 = WS_WOUT + (size_t)DM * DM * 2;
constexpr size_t WS_WFF2 = WS_WFF1 + (size_t)DFF * DM * 2;
constexpr size_t WS_WPOOL = WS_WFF2 + (size_t)DFF * DM * 2;
constexpr size_t WS_MOD = WS_WPOOL + (size_t)1024 * 256 * 2;
constexpr size_t WS_ROPE = WS_MOD + al256((size_t)5 * NMOD * 4);
constexpr size_t WS_BAR = WS_ROPE + 16384;
constexpr size_t WS_ACT = WS_BAR + 16384;
constexpr size_t WS_BIG = WS_ACT + (size_t)MTOT * DM * 2;
constexpr size_t WS_PROJ = WS_BIG;
constexpr size_t WS_Q = WS_PROJ + (size_t)MTOT * NIN * 2;
constexpr size_t WS_KLAT = WS_Q + (size_t)MTOT * 1024 * 2;
constexpr size_t WS_VLAT = WS_KLAT + (size_t)4 * SKV_LAT * 256 * 2;
constexpr size_t WS_KCTX = WS_VLAT + (size_t)4 * SKV_LAT * 256 * 2;
constexpr size_t WS_VCTX = WS_KCTX + (size_t)MCTX * 256 * 2;
constexpr size_t WS_POOLED = WS_VCTX + (size_t)MCTX * 256 * 2;
constexpr size_t WS_BIG_END1 = WS_POOLED + (size_t)MTOT * 1024 * 2;
constexpr size_t WS_H = WS_BIG;
constexpr size_t WS_STATS = WS_H + (size_t)MTOT * DFF * 2;
constexpr size_t WS_PART = WS_STATS + al256((size_t)MTOT * 2 * 4);
constexpr size_t WS_END = WS_PART + (size_t)4096 * DM * 2;
static_assert(WS_BIG_END1 <= WS_END, "aliasing");
constexpr int LDS_BYTES = 131072 + 16;

namespace pg8 {
#define PG8_LAS __attribute__((address_space(3)))
typedef unsigned short bf16_t;
typedef short bf16x8 __attribute__((ext_vector_type(8)));
typedef float f32x4 __attribute__((ext_vector_type(4)));
typedef unsigned u32x4 __attribute__((ext_vector_type(4)));
constexpr int BM = 256, BK = 64, HALF = 128, HTB = HALF * BK * 2  , STAGE_BYTES = 8 * HTB, NXCD = 8, WGM = 8;

__host__ __device__ __forceinline__ int lds_byte(int r, int c) { const int st = (r >> 4) * 2 + (c >> 5), rr = r & 15, cc = c & 31, ob = rr * 64 + cc * 2; return st * 1024 + (ob ^ (((ob >> 9) & 1) << 5)); }
__host__ __device__ __forceinline__ void stage_rc(int b, int& R, int& C) { const int st = b / 1024, sb = b % 1024, swz = sb ^ (((sb >> 9) & 1) << 5); R = (st >> 1) * 16 + swz / 64; C = (st & 1) * 32 + (swz % 64) / 2; }
__host__ __device__ __forceinline__ int perm32(int rho) { const int n = rho >> 4, i = rho & 15; return 8 * (i >> 2) + 4 * n + (i & 3); }

struct Unit { int pm, pn, kt0, nkt, ks; };
struct Gemm { const bf16_t* A; const bf16_t* Bt; int M, N, K, lda, ldb, a_pn_off; };

struct StaticOrder {
    int nM, nN, nwg, G, c;
    __host__ __device__ void init(int M, int N, int G_, int c_) { nM = M / BM; nN = N / BM; nwg = nM * nN; G = G_; c = c_; }
    __host__ __device__ bool next(int i, Unit& u) const {
        const long L = (long)i * G + c; if (L >= nwg) return false;
        int wgid = (int)L; { const int q = nwg / NXCD, r = nwg % NXCD, xcd = wgid % NXCD, off = wgid / NXCD; wgid = (xcd < r ? xcd * (q + 1) : r * (q + 1) + (xcd - r) * q) + off; }
        const int nig = WGM * nN, gid = wgid / nig, fm = gid * WGM, gsz = (nM - fm) < WGM ? (nM - fm) : WGM;
        u.pm = fm + ((wgid % nig) % gsz); u.pn = (wgid % nig) / gsz; return true;
    }
    __device__ __forceinline__ void a_ready(const Unit&) const {}
    __device__ __forceinline__ void done(const Unit&) const {}
};
__device__ __forceinline__ unsigned cvt_pk_bf16(float lo, float hi) { unsigned r; asm volatile("v_cvt_pk_bf16_f32 %0, %1, %2" : "=v"(r) : "v"(lo), "v"(hi)); return r; }
template <class Epi, class Sched, bool TILED = false  , bool STAMP = false>
__device__ __forceinline__ void gemm_phase(PG8_LAS unsigned char* lds, const Gemm g, const Sched& S, const Epi& E, unsigned long long* stamps) {
    int tid_l = threadIdx.x; asm volatile("" : "+v"(tid_l));
    const int tid = tid_l, wid = __builtin_amdgcn_readfirstlane(tid >> 6), lane = tid & 63, wr = wid >> 2, wc = wid & 3, fr = lane & 15, fq = lane >> 4;
    const int K = g.K, nt = K / BK;
    int ts_lo = 0, ts_hi = 0, nts = 0; const unsigned long long rt_entry = STAMP ? (unsigned long long)wall_clock64() : 0ull;
#define PG8_STAMP() do { if (STAMP && wid == 0 && nts < 64) { const unsigned long long _c = (unsigned long long)clock64(); \
        ts_lo = (lane == nts) ? (int)(unsigned)_c : ts_lo; ts_hi = (lane == nts) ? (int)(unsigned)(_c >> 32) : ts_hi; ++nts; } } while (0)
    PG8_STAMP();
    unsigned voffA[2], voffB[2];
#pragma unroll
    for (int i = 0; i < 2; ++i) { int R, C; stage_rc(tid * 16 + i * 8192, R, C); const int Rb = Epi::PERM ? ((R & ~31) + perm32(R & 31)) : R;
        voffA[i] = (unsigned)(R * (TILED ? 64 : g.lda) + C) * 2u; voffB[i] = (unsigned)(Rb * (TILED ? 64 : g.ldb) + C) * 2u; }
    const size_t kstepA = TILED ? (size_t)(256 * 64 * 2) : (size_t)(BK * 2), kstepB = kstepA;
    const size_t hstepA = (size_t)HALF * (TILED ? 64 : g.lda) * 2, hstepB = (size_t)HALF * (TILED ? 64 : g.ldb) * 2;
    const size_t tstepA = TILED ? (size_t)(K / 64) * (256 * 64 * 2) : 2 * hstepA, tstepB = TILED ? tstepA : 2 * hstepB;
    const unsigned ldsw = (unsigned)wid * 1024u;
    const int aoff = lds_byte(wr * 64 + fr, fq * 8), boff = lds_byte(wc * 32 + fr, fq * 8);
#define PG8_SA(b, h) (((b) * 2 + (h)) * HTB)
#define PG8_SB(b, h) ((4 + (b) * 2 + (h)) * HTB)
#define PG8_STAGE(bufoff, gbase, voff) do { _Pragma("unroll") for (int _i = 0; _i < 2; ++_i) \
        __builtin_amdgcn_global_load_lds((const unsigned*)((const char*)(gbase) + (voff)[_i]), (PG8_LAS unsigned*)(lds + (bufoff) + ldsw + _i * 8192), 16, 0, 0); } while (0)
#define PG8_LDA(dst, b, h) do { _Pragma("unroll") for (int m = 0; m < 4; ++m) _Pragma("unroll") for (int k = 0; k < 2; ++k) dst[m][k] = *(const PG8_LAS bf16x8*)(lds + PG8_SA(b, h) + aoff + m * 2048 + k * 1024); } while (0)
#define PG8_LDB(dst, b, h) do { _Pragma("unroll") for (int n = 0; n < 2; ++n) _Pragma("unroll") for (int k = 0; k < 2; ++k) dst[n][k] = *(const PG8_LAS bf16x8*)(lds + PG8_SB(b, h) + boff + n * 2048 + k * 1024); } while (0)
#define PG8_MMA(ai, bj, At, Bt) do { __builtin_amdgcn_s_setprio(1); _Pragma("unroll") for (int m = 0; m < 4; ++m) _Pragma("unroll") for (int n = 0; n < 2; ++n) _Pragma("unroll") for (int k = 0; k < 2; ++k) \
        acc[ai][bj][m][n] = __builtin_amdgcn_mfma_f32_16x16x32_bf16(Bt[n][k], At[m][k], acc[ai][bj][m][n], 0, 0, 0); __builtin_amdgcn_s_setprio(0); } while (0)
#define PG8_WAIT_V(n) asm volatile("s_waitcnt vmcnt(" #n ")" ::: "memory")
#define PG8_WAIT_L(n) asm volatile("s_waitcnt lgkmcnt(" #n ")" ::: "memory")
#define PG8_BAR __builtin_amdgcn_s_barrier()
#define PG8_SCHED __builtin_amdgcn_sched_barrier(0)
    Unit cur, nxt; int ui = 0; cur.kt0 = 0; cur.nkt = nt; cur.ks = 0;
    if (!S.next(0, cur)) return;
    f32x4 acc[2][2][4][2];
#pragma unroll
    for (int a = 0; a < 2; ++a)
#pragma unroll
        for (int b = 0; b < 2; ++b)
#pragma unroll
            for (int m = 0; m < 4; ++m)
#pragma unroll
                for (int n = 0; n < 2; ++n) acc[a][b][m][n] = (f32x4){0.f, 0.f, 0.f, 0.f};
    bf16x8 At[4][2], B0[2][2], B1[2][2];
    const char* cA = (const char*)g.A + (size_t)cur.pm * tstepA + (size_t)cur.pn * g.a_pn_off + (size_t)cur.kt0 * kstepA; const char* cB = (const char*)g.Bt + (size_t)cur.pn * tstepB + (size_t)cur.kt0 * kstepB;
    S.a_ready(cur);
    PG8_STAGE(PG8_SB(0, 0), cB, voffB); PG8_STAGE(PG8_SA(0, 0), cA, voffA); PG8_STAGE(PG8_SB(0, 1), cB + hstepB, voffB); PG8_STAGE(PG8_SA(0, 1), cA + hstepA, voffA);
    if (wr == 1) PG8_BAR;
    PG8_WAIT_V(4); PG8_BAR;
    PG8_STAGE(PG8_SB(1, 0), cB + kstepB, voffB); PG8_STAGE(PG8_SA(1, 0), cA + kstepA, voffA); PG8_STAGE(PG8_SB(1, 1), cB + hstepB + kstepB, voffB);
    PG8_WAIT_V(6); PG8_BAR;
    PG8_STAMP();
    for (;;) {
        nxt.kt0 = 0; nxt.nkt = nt; nxt.ks = 0;
        const bool has_next = S.next(ui + 1, nxt);
        const char* nA = has_next ? (const char*)g.A + (size_t)nxt.pm * tstepA + (size_t)nxt.pn * g.a_pn_off + (size_t)nxt.kt0 * kstepA : cA; const char* nB = has_next ? (const char*)g.Bt + (size_t)nxt.pn * tstepB + (size_t)nxt.kt0 * kstepB : cB;
        const int cnt = cur.nkt;
        for (int t = 0; t < cnt; t += 2) {
            const bool last = (t == cnt - 2);
            const char* a1 = cA + (size_t)(t + 1) * kstepA;
            const char* a2 = last ? nA : cA + (size_t)(t + 2) * kstepA; const char* b2 = last ? nB : cB + (size_t)(t + 2) * kstepB;
            const char* a3 = a2 + kstepA; const char* b3 = b2 + kstepB;
            if (last && has_next) S.a_ready(nxt);
            PG8_LDB(B0, 0, 0); PG8_SCHED; PG8_LDA(At, 0, 0); PG8_STAGE(PG8_SA(1, 1), a1 + hstepA, voffA);
            PG8_WAIT_L(8); PG8_BAR; PG8_WAIT_L(0); PG8_MMA(0, 0, At, B0); PG8_BAR; PG8_SCHED;
            PG8_LDB(B1, 0, 1); PG8_STAGE(PG8_SB(0, 0), b2, voffB);
            PG8_BAR; PG8_WAIT_L(0); PG8_MMA(0, 1, At, B1); PG8_BAR;
            PG8_LDA(At, 0, 1); PG8_STAGE(PG8_SA(0, 0), a2, voffA);
            PG8_BAR; PG8_WAIT_L(0); PG8_MMA(1, 0, At, B0); PG8_BAR; PG8_SCHED;
            PG8_STAGE(PG8_SB(0, 1), b2 + hstepB, voffB);
            PG8_WAIT_V(6); PG8_BAR; PG8_MMA(1, 1, At, B1); PG8_BAR;
            PG8_LDB(B0, 1, 0); PG8_SCHED; PG8_LDA(At, 1, 0); PG8_STAGE(PG8_SA(0, 1), a2 + hstepA, voffA);
            PG8_WAIT_L(8); PG8_BAR; PG8_WAIT_L(0); PG8_MMA(0, 0, At, B0); PG8_BAR; PG8_SCHED;
            PG8_LDB(B1, 1, 1); PG8_STAGE(PG8_SB(1, 0), b3, voffB);
            PG8_BAR; PG8_WAIT_L(0); PG8_MMA(0, 1, At, B1); PG8_BAR;
            PG8_LDA(At, 1, 1); PG8_STAGE(PG8_SA(1, 0), a3, voffA);
            PG8_BAR; PG8_WAIT_L(0); PG8_MMA(1, 0, At, B0); PG8_BAR; PG8_SCHED;
            PG8_STAGE(PG8_SB(1, 1), b3 + hstepB, voffB);
            PG8_WAIT_V(6); PG8_BAR; PG8_MMA(1, 1, At, B1); PG8_BAR;
        }
        PG8_STAMP();
        if constexpr (!Epi::AFTER_DRAIN) { E(acc, cur, wr, wc, fr, fq); S.done(cur); }
        PG8_STAMP();
        if (!has_next) break;
#pragma unroll
        for (int a = 0; a < 2; ++a)
#pragma unroll
            for (int b = 0; b < 2; ++b)
#pragma unroll
                for (int m = 0; m < 4; ++m)
#pragma unroll
                    for (int n = 0; n < 2; ++n) acc[a][b][m][n] = (f32x4){0.f, 0.f, 0.f, 0.f};
        cur = nxt; cA = nA; cB = nB; ++ui;
    }
    PG8_WAIT_V(0);
    if (wr == 0) PG8_BAR;
    PG8_BAR;
    if constexpr (Epi::AFTER_DRAIN) { E.fused(acc, cur, wr, wc, fr, fq, lds, wid, lane); S.done(cur); }
    PG8_STAMP();
    if (STAMP && wid == 0) { stamps[lane] = lane < nts ? (((unsigned long long)(unsigned)ts_hi << 32) | (unsigned)ts_lo) : 0ull;
        if (lane == 62) stamps[62] = rt_entry; if (lane == 63) stamps[63] = (unsigned long long)wall_clock64(); }
#undef PG8_STAMP
#undef PG8_SA
#undef PG8_SB
#undef PG8_STAGE
#undef PG8_LDA
#undef PG8_LDB
#undef PG8_MMA
#undef PG8_WAIT_V
#undef PG8_WAIT_L
#undef PG8_BAR
#undef PG8_SCHED
}
}
namespace att {
using bf16 = __hip_bfloat16;
constexpr int   D = 128, NW = 8, QBLK = 32, KVBLK = 64;
constexpr float SCALE = 0.088388347648318440f;
constexpr float THR = 8.f;
#ifndef ATT_SDEPTH
#define ATT_SDEPTH 2
#endif
constexpr int SDEPTH = ATT_SDEPTH;
constexpr int LDQ = 2560, LDK = 256, LDO = 2048;
constexpr size_t SHM_V = KVBLK * D * 2, SHM_K = KVBLK * D * 2, SHM_ATTN = 2 * SHM_V + 2 * SHM_K + NW * 64 * 4;
using bf16x8 = __attribute__((ext_vector_type(8))) short;
using s16x4  = __attribute__((ext_vector_type(4))) short;
using f32x16 = __attribute__((ext_vector_type(16))) float;
using f32x8  = __attribute__((ext_vector_type(8))) float;
using u32x4  = __attribute__((ext_vector_type(4))) unsigned;
#define KSWZ(row, colB) ((row) * 256 + ((colB) ^ (((row) & 7) << 4)))
#define SBAR() __builtin_amdgcn_sched_barrier(0)
__device__ __forceinline__ int crow(int r, int hi) { return (r & 3) + 8 * (r >> 2) + 4 * hi; }
__device__ __forceinline__ unsigned cvtpk(float lo, float hi) {
  unsigned r; asm volatile("v_cvt_pk_bf16_f32 %0, %1, %2" : "=v"(r) : "v"(lo), "v"(hi)); return r;
}
template <typename TIn> struct Stage;
template <> struct Stage<bf16>  { using T = bf16x8;
  __device__ static __forceinline__ T ld8(const bf16* p) { return *reinterpret_cast<const bf16x8*>(p); }
  __device__ static __forceinline__ bf16x8 tobf(T x) { return x; } };
template <> struct Stage<float> { using T = f32x8;
  __device__ static __forceinline__ T ld8(const float* p) { return *reinterpret_cast<const f32x8*>(p); }
  __device__ static __forceinline__ bf16x8 tobf(T x) {
    u32x4 w = {cvtpk(x[0], x[1]), cvtpk(x[2], x[3]), cvtpk(x[4], x[5]), cvtpk(x[6], x[7])}; return *reinterpret_cast<bf16x8*>(&w); } };

__device__ __forceinline__ void partialSM(f32x16& p0, f32x16& p1, float& m_reg, float& mn, float& alpha) {
  constexpr float C = SCALE * 1.4426950408889634f;
  float pmax = p0[0]; for (int r = 1; r < 16; ++r) pmax = fmaxf(pmax, p0[r]); for (int r = 0; r < 16; ++r) pmax = fmaxf(pmax, p1[r]);
  { auto rr = __builtin_amdgcn_permlane32_swap(__float_as_uint(pmax), __float_as_uint(pmax), false, false);
    pmax = fmaxf(__uint_as_float(rr[0]), __uint_as_float(rr[1])); }
  if (__builtin_expect(__all(pmax - m_reg <= THR / SCALE), 1)) { mn = m_reg; alpha = 1.f; }
  else { mn = fmaxf(m_reg, pmax); alpha = __builtin_amdgcn_exp2f((m_reg - mn) * C); m_reg = mn; }
  float mnC = -mn * C;
  for (int r = 0; r < 16; ++r) p0[r] = fmaf(p0[r], C, mnC); for (int r = 0; r < 16; ++r) p1[r] = fmaf(p1[r], C, mnC);
  for (int r = 0; r < 16; ++r) p0[r] = __builtin_amdgcn_exp2f(p0[r]);
}
__device__ __forceinline__ void finishSM(f32x16& p0, f32x16& p1, float alpha, float& l_reg, bf16x8& pa0, bf16x8& pa1, bf16x8& pa2, bf16x8& pa3) {
  for (int r = 0; r < 16; ++r) p1[r] = __builtin_amdgcn_exp2f(p1[r]);
  float ps = 0; for (int r = 0; r < 16; ++r) ps += p0[r]; for (int r = 0; r < 16; ++r) ps += p1[r];
  { auto rr = __builtin_amdgcn_permlane32_swap(__float_as_uint(ps), __float_as_uint(ps), false, false);
    ps = __uint_as_float(rr[0]) + __uint_as_float(rr[1]); }
  l_reg = l_reg * alpha + ps;
#define PK4(P, BASE, OUT) do { unsigned a0 = cvtpk(P[BASE + 0], P[BASE + 1]), a1 = cvtpk(P[BASE + 2], P[BASE + 3]);   \
    unsigned b0 = cvtpk(P[BASE + 4], P[BASE + 5]), b1 = cvtpk(P[BASE + 6], P[BASE + 7]);                              \
    auto r0 = __builtin_amdgcn_permlane32_swap(a0, b0, false, false); auto r1 = __builtin_amdgcn_permlane32_swap(a1, b1, false, false); \
    u32x4 w = {r0[0], r1[0], r0[1], r1[1]}; OUT = *reinterpret_cast<bf16x8*>(&w); } while (0)
  PK4(p0, 0, pa0); PK4(p0, 8, pa1); PK4(p1, 0, pa2); PK4(p1, 8, pa3);
#undef PK4
}
__device__ __forceinline__ void qkt(f32x16& p0, f32x16& p1, const bf16* Ks, const bf16x8* qr, int r32, int hi) {
  p0 = f32x16{}; p1 = f32x16{};
  for (int d0 = 0; d0 < 8; ++d0) { int cb = (d0 * 16 + hi * 8) * 2;
    bf16x8 b0 = *reinterpret_cast<const bf16x8*>((const char*)Ks + KSWZ(r32, cb));
    bf16x8 b1 = *reinterpret_cast<const bf16x8*>((const char*)Ks + KSWZ(32 + r32, cb));
    p0 = __builtin_amdgcn_mfma_f32_32x32x16_bf16(b0, qr[d0], p0, 0, 0, 0);
    p1 = __builtin_amdgcn_mfma_f32_32x32x16_bf16(b1, qr[d0], p1, 0, 0, 0); }
}
__device__ __forceinline__ int v_st(int k, int c) { const int kk = (k & ~0xC) | ((k & 4) << 1) | ((k & 8) >> 1); return ((kk >> 3) * 4 + (c >> 5)) * 512 + ((kk & 7) * 32 + (c & 31)) * 2; }
__device__ __forceinline__ int v_rd_base(int lane) { return ((lane & 3) << 3) | (((lane >> 2) & 3) << 6) | (((lane >> 4) & 1) << 5) | (((lane >> 5) & 1) << 8); }
constexpr int v_rd_off(int d0, int ks, int half) { return d0 * 512 + ks * 4096 + half * 2048; }
template <int OFF> __device__ __forceinline__ s16x4 tr_read(int vb) {
  s16x4 r; asm volatile("ds_read_b64_tr_b16 %0, %1 offset:%2" : "=&v"(r) : "v"(vb), "i"(OFF) : "memory"); return r;
}
template <int D0> __device__ __forceinline__ void pv_one(f32x16& od, int vb, bf16x8 pa0, bf16x8 pa1, bf16x8 pa2, bf16x8 pa3) {
  const s16x4 l0 = tr_read<v_rd_off(D0, 0, 0)>(vb), h0 = tr_read<v_rd_off(D0, 0, 1)>(vb), l1 = tr_read<v_rd_off(D0, 1, 0)>(vb), h1 = tr_read<v_rd_off(D0, 1, 1)>(vb);
  const s16x4 l2 = tr_read<v_rd_off(D0, 2, 0)>(vb), h2 = tr_read<v_rd_off(D0, 2, 1)>(vb), l3 = tr_read<v_rd_off(D0, 3, 0)>(vb), h3 = tr_read<v_rd_off(D0, 3, 1)>(vb);
  asm volatile("s_waitcnt lgkmcnt(0)" ::: "memory"); SBAR();
#define PK(L, H) (bf16x8){L[0], L[1], L[2], L[3], H[0], H[1], H[2], H[3]}
  od = __builtin_amdgcn_mfma_f32_32x32x16_bf16(pa0, PK(l0, h0), od, 0, 0, 0);
  od = __builtin_amdgcn_mfma_f32_32x32x16_bf16(pa1, PK(l1, h1), od, 0, 0, 0);
  od = __builtin_amdgcn_mfma_f32_32x32x16_bf16(pa2, PK(l2, h2), od, 0, 0, 0);
  od = __builtin_amdgcn_mfma_f32_32x32x16_bf16(pa3, PK(l3, h3), od, 0, 0, 0);
#undef PK
}
__device__ __forceinline__ void pv_d0(f32x16* o, int vb, bf16x8 pa0, bf16x8 pa1, bf16x8 pa2, bf16x8 pa3) {
  pv_one<0>(o[0], vb, pa0, pa1, pa2, pa3); pv_one<1>(o[1], vb, pa0, pa1, pa2, pa3); pv_one<2>(o[2], vb, pa0, pa1, pa2, pa3); pv_one<3>(o[3], vb, pa0, pa1, pa2, pa3);
}

template <typename TQ>
__device__ __forceinline__ void attn_dense_body(const TQ* __restrict__ Qb, const bf16* __restrict__ Kh, const bf16* __restrict__ Vh,
                                                unsigned short* __restrict__ Ob, int orow0, int ocol0, int seq, char* lds,
                                                const float* __restrict__ qgain, const float* __restrict__ ropeC, const float* __restrict__ ropeS, int s0, bool lat) {
  using St = Stage<bf16>; using SQ = Stage<TQ>;
  int tid_l = threadIdx.x; asm volatile("" : "+v"(tid_l));
  const int tid = tid_l, wid = tid >> 6, lane = tid & 63, r32 = lane & 31, hi = lane >> 5;
  bf16* V_lds = (bf16*)lds; bf16* K_lds = (bf16*)(lds + 2 * SHM_V);
  float* ws = (float*)(lds + 2 * SHM_V + 2 * SHM_K) + wid * 64; float* li_l = ws; float* al_l = ws + 32;
  float m_reg = -1e30f, l_reg = 0; f32x16 o[4] = {}; bf16x8 qr[8];
  const TQ* Qw = Qb + (long)(wid * QBLK + r32) * LDQ + hi * 8;
#pragma unroll
  for (int d0 = 0; d0 < 8; ++d0) qr[d0] = SQ::tobf(SQ::ld8(Qw + d0 * 16));
  {
    float xq[8][8];
#pragma unroll
    for (int d0 = 0; d0 < 8; ++d0) { const u32x4 w = *reinterpret_cast<const u32x4*>(&qr[d0]);
      xq[d0][0] = __uint_as_float(w.x << 16); xq[d0][1] = __uint_as_float(w.x & 0xffff0000u); xq[d0][2] = __uint_as_float(w.y << 16); xq[d0][3] = __uint_as_float(w.y & 0xffff0000u);
      xq[d0][4] = __uint_as_float(w.z << 16); xq[d0][5] = __uint_as_float(w.z & 0xffff0000u); xq[d0][6] = __uint_as_float(w.w << 16); xq[d0][7] = __uint_as_float(w.w & 0xffff0000u); }
    float ss = 0.f;
#pragma unroll
    for (int d0 = 0; d0 < 8; ++d0)
#pragma unroll
      for (int e = 0; e < 8; ++e) ss += xq[d0][e] * xq[d0][e];
    { auto rr = __builtin_amdgcn_permlane32_swap(__float_as_uint(ss), __float_as_uint(ss), false, false); ss = __uint_as_float(rr[0]) + __uint_as_float(rr[1]); }
    const float rinv = 1.0f / sqrtf(ss * (1.f / 128.f) + 1e-6f);
#pragma unroll
    for (int d0 = 0; d0 < 8; ++d0) { const float* gp = qgain + d0 * 16 + hi * 8;
      const float4 g0 = *reinterpret_cast<const float4*>(gp), g1 = *reinterpret_cast<const float4*>(gp + 4);
      xq[d0][0] *= rinv * g0.x; xq[d0][1] *= rinv * g0.y; xq[d0][2] *= rinv * g0.z; xq[d0][3] *= rinv * g0.w;
      xq[d0][4] *= rinv * g1.x; xq[d0][5] *= rinv * g1.y; xq[d0][6] *= rinv * g1.z; xq[d0][7] *= rinv * g1.w; }
    if (lat) {
      const int spos = s0 + wid * QBLK + r32;
#pragma unroll
      for (int part = 0; part < 2; ++part) { const int pos = part ? (spos & 63) : (spos >> 6);
#pragma unroll
        for (int q2 = 0; q2 < 2; ++q2) { const int a = part * 4 + q2, b = a + 2; const int fi0 = q2 * 16 + hi * 8;
          const float* cp = ropeC + pos * 32 + fi0; const float* sp = ropeS + pos * 32 + fi0;
          const float4 c0 = *reinterpret_cast<const float4*>(cp), c1 = *reinterpret_cast<const float4*>(cp + 4), n0 = *reinterpret_cast<const float4*>(sp), n1 = *reinterpret_cast<const float4*>(sp + 4);
          const float cc[8] = {c0.x, c0.y, c0.z, c0.w, c1.x, c1.y, c1.z, c1.w}, sn[8] = {n0.x, n0.y, n0.z, n0.w, n1.x, n1.y, n1.z, n1.w};
#pragma unroll
          for (int e = 0; e < 8; ++e) { const float x1 = xq[a][e], x2 = xq[b][e]; xq[a][e] = x1 * cc[e] - x2 * sn[e]; xq[b][e] = x2 * cc[e] + x1 * sn[e]; } } }
    }
#pragma unroll
    for (int d0 = 0; d0 < 8; ++d0) { u32x4 w = {cvtpk(xq[d0][0], xq[d0][1]), cvtpk(xq[d0][2], xq[d0][3]), cvtpk(xq[d0][4], xq[d0][5]), cvtpk(xq[d0][6], xq[d0][7])}; qr[d0] = *reinterpret_cast<bf16x8*>(&w); }
  }
  const int sr = tid >> 4, sc = (tid & 15) * 8, vst0 = v_st(sr, sc), vst1 = v_st(32 + sr, sc);
  const int vb0 = (int)(uintptr_t)V_lds + v_rd_base(lane);
  struct { typename St::T vs0, vs1, ks0, ks1; } sr_[SDEPTH];
#define SLOAD(i, k0) do { sr_[i].vs0 = St::ld8(&Vh[(long)((k0) + sr) * LDK + sc]); sr_[i].vs1 = St::ld8(&Vh[(long)((k0) + 32 + sr) * LDK + sc]); \
    sr_[i].ks0 = St::ld8(&Kh[(long)((k0) + sr) * LDK + sc]); sr_[i].ks1 = St::ld8(&Kh[(long)((k0) + 32 + sr) * LDK + sc]); } while (0)
#define SWRITE(b, i) do { *(bf16x8*)((char*)V_lds + (b) * SHM_V + vst0) = St::tobf(sr_[i].vs0);          \
    *(bf16x8*)((char*)V_lds + (b) * SHM_V + vst1) = St::tobf(sr_[i].vs1); int kc = sc * 2;               \
    *(bf16x8*)((char*)K_lds + (b) * SHM_K + KSWZ(sr, kc)) = St::tobf(sr_[i].ks0);                       \
    *(bf16x8*)((char*)K_lds + (b) * SHM_K + KSWZ(32 + sr, kc)) = St::tobf(sr_[i].ks1); } while (0)
#define SWAIT() do { if constexpr (SDEPTH == 2) asm volatile("s_waitcnt vmcnt(4)" ::: "memory"); else asm volatile("s_waitcnt vmcnt(0)" ::: "memory"); } while (0)
#define RESC(a) do { if (__any((a) < 1.f)) { if (hi == 0) al_l[r32] = (a); asm volatile("s_waitcnt lgkmcnt(0)" ::: "memory"); \
    for (int d = 0; d < 4; ++d) for (int r = 0; r < 16; ++r) o[d][r] *= al_l[crow(r, hi)]; } } while (0)
  f32x16 pA0, pA1, pB0, pB1; float mnA, mnB, alA, alB; bf16x8 pa0, pa1, pa2, pa3; const int NT = seq / KVBLK;
  constexpr int SE = 0, SO = SDEPTH - 1;
  SLOAD(SE, 0); asm volatile("s_waitcnt vmcnt(0)" ::: "memory"); SWRITE(0, SE); __syncthreads();
  qkt(pA0, pA1, K_lds, qr, r32, hi); partialSM(pA0, pA1, m_reg, mnA, alA);
  SLOAD(SO, KVBLK); if constexpr (SDEPTH == 2) { if (2 < NT) SLOAD(SE, 2 * KVBLK); }
  SWAIT(); SWRITE(1, SO); __syncthreads();
  for (int j = 1; j + 1 < NT; j += 2) {
    SBAR(); qkt(pB0, pB1, (bf16*)((char*)K_lds + SHM_K), qr, r32, hi);
    finishSM(pA0, pA1, alA, l_reg, pa0, pa1, pa2, pa3); SBAR();
    SLOAD(SO, (j + SDEPTH) * KVBLK); SBAR();
    pv_d0(o, vb0, pa0, pa1, pa2, pa3); partialSM(pB0, pB1, m_reg, mnB, alB);
    __syncthreads(); SWAIT(); SWRITE(0, SE);
    RESC(alB); __syncthreads();
    SBAR(); qkt(pA0, pA1, K_lds, qr, r32, hi);
    finishSM(pB0, pB1, alB, l_reg, pa0, pa1, pa2, pa3); SBAR();
    if (SDEPTH == 1 || j + 3 < NT) SLOAD(SE, (j + 1 + SDEPTH) * KVBLK); SBAR();
    pv_d0(o, vb0 + (int)SHM_V, pa0, pa1, pa2, pa3); partialSM(pA0, pA1, m_reg, mnA, alA);
    __syncthreads(); SWAIT(); SWRITE(1, SO);
    RESC(alA); __syncthreads();
  }
  SBAR(); qkt(pB0, pB1, (bf16*)((char*)K_lds + SHM_K), qr, r32, hi);
  finishSM(pA0, pA1, alA, l_reg, pa0, pa1, pa2, pa3); SBAR();
  pv_d0(o, vb0, pa0, pa1, pa2, pa3); partialSM(pB0, pB1, m_reg, mnB, alB);
  __syncthreads(); RESC(alB);
  finishSM(pB0, pB1, alB, l_reg, pa0, pa1, pa2, pa3); SBAR();
  pv_d0(o, vb0 + (int)SHM_V, pa0, pa1, pa2, pa3);
  if (hi == 0) li_l[r32] = l_reg; asm volatile("s_waitcnt lgkmcnt(0)" ::: "memory");
  float rli[16];
#pragma unroll
  for (int r = 0; r < 16; ++r) rli[r] = __builtin_amdgcn_rcpf(li_l[crow(r, hi)]);
  unsigned short* Op = Ob + (((long)(orow0 >> 8) * 32 + (ocol0 >> 6)) * 256 + wid * QBLK) * 64 + r32 + hi * 256;
#pragma unroll
  for (int r = 0; r < 16; ++r) { int orow = crow(r, hi);
    for (int d0 = 0; d0 < 4; ++d0) Op[((r & 3) + 8 * (r >> 2)) * 64 + (d0 >> 1) * 16384 + (d0 & 1) * 32] = (unsigned short)(cvtpk(o[d0][r] * rli[r], 0.f) & 0xffffu); }
#undef SLOAD
#undef SWRITE
#undef SWAIT
#undef RESC
}
}
#define XB_TMO      128
#define XB_XCNT(j)  (256  + 64 * (j))
#define XB_XSUB(j)  (1280 + 64 * (j))
#define XB_XGEN(j)  (2304 + 64 * (j))
#define XB_TOP      3328
#define XB_TOPGEN   3392
#define XCD_BAR_WORDS 3456
#define XB_SPIN_CAP (1u << 18)
#define LAS __attribute__((address_space(3)))

__device__ __forceinline__ unsigned xb_ld(unsigned* p)              { return __hip_atomic_load(p, __ATOMIC_RELAXED, __HIP_MEMORY_SCOPE_AGENT); }
__device__ __forceinline__ unsigned xb_add(unsigned* p, unsigned v) { return __hip_atomic_fetch_add(p, v, __ATOMIC_RELAXED, __HIP_MEMORY_SCOPE_AGENT); }
__device__ __forceinline__ unsigned xb_xcc_id() { return (unsigned)__builtin_amdgcn_s_getreg((3 << 11) | 20) & 0xFu; }
#define XB_SPIN(cond, bar) do { unsigned _sp = 0; while (cond) { __builtin_amdgcn_s_sleep(1); \
    if ((++_sp & 255u) == 0u) { if (xb_ld(&(bar)[XB_TMO])) break; if (_sp > XB_SPIN_CAP) { atomicAdd(&(bar)[XB_TMO], 1u); break; } } } } while (0)

struct XcdBarrier {
    unsigned* bar; unsigned x;
    volatile LAS unsigned* st;
};

__device__ __forceinline__ XcdBarrier xcd_barrier_post(unsigned* bar, volatile LAS unsigned* st) {
    XcdBarrier b; b.bar = bar; b.x = xb_xcc_id(); b.st = st;
    if (threadIdx.x == 0) (void)xb_add(&bar[XB_XCNT(b.x)], 1u);
    return b;
}
__device__ __forceinline__ void xcd_barrier_complete(unsigned* bar, unsigned x, unsigned& nloc, unsigned& nx) {
    const unsigned G = gridDim.x * gridDim.y * gridDim.z;
    unsigned sum, cnt, mine, sp = 0u;
    for (;;) {
        sum = 0u; cnt = 0u; mine = 0u;
#pragma unroll
        for (unsigned j = 0; j < 16; ++j) { const unsigned c = xb_ld(&bar[XB_XCNT(j)]); sum += c; cnt += (c > 0u) ? 1u : 0u; mine = (j == x) ? c : mine; }
        if (sum == G) break;
        __builtin_amdgcn_s_sleep(1);
        if ((++sp & 255u) == 0u) { if (xb_ld(&bar[XB_TMO])) break; if (sp > XB_SPIN_CAP) { atomicAdd(&bar[XB_TMO], 1u); break; } }
    }
    nloc = mine > 0u ? mine : 1u; nx = cnt > 0u ? cnt : 1u;
}

__device__ __forceinline__ void xcd_barrier(const XcdBarrier& b) {
    asm volatile("s_waitcnt vmcnt(0)" ::: "memory");
    __syncthreads();
    if (threadIdx.x == 0) {
        unsigned* bar = b.bar;
        __builtin_amdgcn_s_waitcnt(0);
        unsigned nloc = b.st[0], nx = b.st[1];
        if (nloc == 0u) { xcd_barrier_complete(bar, b.x, nloc, nx); b.st[0] = nloc; b.st[1] = nx; }
        const unsigned old = xb_add(&bar[XB_XSUB(b.x)], 1u);
        const unsigned gen = old / nloc;
        if (old + 1u == (gen + 1u) * nloc) {
            __builtin_amdgcn_fence(__ATOMIC_RELEASE, "agent");
            asm volatile("s_waitcnt vmcnt(0)" ::: "memory");
            const unsigned og = xb_add(&bar[XB_TOP], 1u);
            const unsigned tg = og / nx;
            if (og + 1u == (tg + 1u) * nx) xb_add(&bar[XB_TOPGEN], 1u);
            else XB_SPIN(xb_ld(&bar[XB_TOPGEN]) == tg, bar);
            __builtin_amdgcn_fence(__ATOMIC_ACQUIRE, "agent");
            xb_add(&bar[XB_XGEN(b.x)], 1u);
            asm volatile("s_waitcnt vmcnt(0)" ::: "memory");
        } else {
            XB_SPIN(xb_ld(&bar[XB_XGEN(b.x)]) == gen, bar);
            __builtin_amdgcn_fence(__ATOMIC_ACQUIRE, "agent");
            asm volatile("s_waitcnt vmcnt(0)" ::: "memory");
        }
    }
    __syncthreads();
}


using pg8::bf16_t; using pg8::f32x4; using pg8::u32x4; using pg8::Unit; using pg8::cvt_pk_bf16;
typedef unsigned u32x2 __attribute__((ext_vector_type(2)));
struct Args { const float* in[20]; float* out; unsigned char* ws; };
enum { I_XP = 0, I_XS, I_CK, I_CV, I_C, I_CCTX, I_WMOD, I_BMOD, I_WIN, I_QG, I_KG, I_WPOOL, I_PSCALE, I_WOUT, I_LN1G, I_LN1B, I_WFF1, I_WFF2, I_LN2G, I_LN2B };

template <int CTRL> __device__ __forceinline__ float dpp_f(float v) { return __int_as_float(__builtin_amdgcn_update_dpp(0, __float_as_int(v), CTRL, 0xF, 0xF, true)); }
__device__ __forceinline__ float wave_sum(float v) {
    v += dpp_f<0xB1>(v); v += dpp_f<0x4E>(v); v += dpp_f<0x141>(v); v += dpp_f<0x140>(v);
    { auto r = __builtin_amdgcn_permlane16_swap(__float_as_uint(v), __float_as_uint(v), false, false); v = __uint_as_float(r[0]) + __uint_as_float(r[1]); }
    { auto r = __builtin_amdgcn_permlane32_swap(__float_as_uint(v), __float_as_uint(v), false, false); v = __uint_as_float(r[0]) + __uint_as_float(r[1]); }
    return v;
}
__device__ __forceinline__ float bf_lo(unsigned w) { return __uint_as_float(w << 16); }
__device__ __forceinline__ float bf_hi(unsigned w) { return __uint_as_float(w & 0xffff0000u); }
__device__ __forceinline__ int mod_row_of(int row) { return row < MCTX ? 4 : ((row - MCTX) >> 12); }
__device__ __forceinline__ const float* x_row(const Args& a, int row) { return row < MCTX ? a.in[I_XP] + (size_t)row * DM : a.in[I_XS] + (size_t)(row - MCTX) * DM; }

__device__ __forceinline__ size_t tiled_off(int row, int col, int kt_row) { return ((((size_t)(row >> 8) * kt_row + (col >> 6)) * 256 + (row & 255)) * 64 + (col & 63)); }
template <int ACT  , bool CS  > struct EpiB {
    static constexpr bool PERM = true, AFTER_DRAIN = false;
    bf16_t* O; int ldc; const float* cs; int kt_row, colbase;
    __device__ __forceinline__ void operator()(const f32x4 (&acc)[2][2][4][2], const Unit& u, int wr, int wc, int fr, int fq) const {
        const int row0 = u.pm * 256 + wr * 64 + fr, col0 = u.pn * 256 + wc * 32 + 8 * fq;
        bf16_t* base; size_t s_row, s_bj;
        if (kt_row) { base = O + (((size_t)u.pm * kt_row + (colbase >> 6) + u.pn * 4 + (wc >> 1)) * 256 + wr * 64 + fr) * 64 + (wc & 1) * 32 + 8 * fq; s_row = 64; s_bj = (size_t)2 * 256 * 64; }
        else { base = O + (size_t)row0 * ldc + col0; s_row = (size_t)ldc; s_bj = 128; }
#pragma unroll
        for (int bj = 0; bj < 2; ++bj) {
            f32x4 sv0 = {1.f, 1.f, 1.f, 1.f}, sv1 = sv0;
            if (CS) { sv0 = *(const f32x4*)(cs + col0 + bj * 128); sv1 = *(const f32x4*)(cs + col0 + bj * 128 + 4); }
#pragma unroll
            for (int ai = 0; ai < 2; ++ai)
#pragma unroll
                for (int m = 0; m < 4; ++m) { bf16_t* rowp = base + (size_t)(ai * 128 + m * 16) * s_row + bj * s_bj;
                    f32x4 v0 = acc[ai][bj][m][0], v1 = acc[ai][bj][m][1];
                    if (ACT == 1) {
#pragma unroll
                        for (int j = 0; j < 4; ++j) { const float r0 = fmaxf(v0[j], 0.f), r1 = fmaxf(v1[j], 0.f); v0[j] = r0 * r0; v1[j] = r1 * r1; } }
                    if (CS) { v0 = v0 * sv0; v1 = v1 * sv1; }
                    u32x4 w; w.x = cvt_pk_bf16(v0[0], v0[1]); w.y = cvt_pk_bf16(v0[2], v0[3]); w.z = cvt_pk_bf16(v1[0], v1[1]); w.w = cvt_pk_bf16(v1[2], v1[3]);
                    *(u32x4*)rowp = w; }
            asm volatile("" ::: "memory");
        }
    }
};
struct EpiPre1 {
    static constexpr bool PERM = true, AFTER_DRAIN = false;
    const float* __restrict__ xp; const float* __restrict__ xs; bf16_t* __restrict__ pre; const float* __restrict__ gate;
    __device__ __forceinline__ void operator()(const f32x4 (&acc)[2][2][4][2], const Unit& u, int wr, int wc, int fr, int fq) const {
        const int row0 = u.pm * 256 + wr * 64 + fr, col0 = u.pn * 256 + wc * 32 + 8 * fq;
        const int mrow = u.pm < 16 ? 4 : ((u.pm - 16) >> 4);
        const float* gp = gate + (size_t)mrow * NMOD + col0;
        f32x4 gv[2][2];
#pragma unroll
        for (int bj = 0; bj < 2; ++bj)
#pragma unroll
            for (int n = 0; n < 2; ++n) gv[bj][n] = *(const f32x4*)(gp + bj * 128 + n * 4);
#pragma unroll
        for (int ai = 0; ai < 2; ++ai) {
            f32x4 xv[4][2][2];
#pragma unroll
            for (int m = 0; m < 4; ++m) { const int row = row0 + ai * 128 + m * 16;
                const float* xr = (row < MCTX ? xp + (size_t)row * DM : xs + (size_t)(row - MCTX) * DM) + col0;
#pragma unroll
                for (int bj = 0; bj < 2; ++bj)
#pragma unroll
                    for (int n = 0; n < 2; ++n) xv[m][bj][n] = *(const f32x4*)(xr + bj * 128 + n * 4); }
#pragma unroll
            for (int m = 0; m < 4; ++m) { bf16_t* prow = pre + (size_t)(row0 + ai * 128 + m * 16) * DM + col0;
#pragma unroll
                for (int bj = 0; bj < 2; ++bj) { const f32x4 v0 = xv[m][bj][0] * ALPHA + gv[bj][0] * acc[ai][bj][m][0], v1 = xv[m][bj][1] * ALPHA + gv[bj][1] * acc[ai][bj][m][1];
                    u32x4 w; w.x = cvt_pk_bf16(v0[0], v0[1]); w.y = cvt_pk_bf16(v0[2], v0[3]); w.z = cvt_pk_bf16(v1[0], v1[1]); w.w = cvt_pk_bf16(v1[2], v1[3]);
                    *(u32x4*)(prow + bj * 128) = w; } }
            asm volatile("" ::: "memory");
        }
    }
};
struct EpiPre2 {
    static constexpr bool PERM = true, AFTER_DRAIN = false;
    const bf16_t* __restrict__ pre1; const float* __restrict__ stats; const float* __restrict__ g1; const float* __restrict__ b1; bf16_t* __restrict__ pre2; const float* __restrict__ gate; bf16_t* __restrict__ part;
    __device__ __forceinline__ void operator()(const f32x4 (&acc)[2][2][4][2], const Unit& u, int wr, int wc, int fr, int fq) const {
        int pn_l = u.pn; asm volatile("" : "+s"(pn_l));
        const int row0 = u.pm * 256 + wr * 64 + fr, col0 = pn_l * 256 + wc * 32 + 8 * fq;
        const int mrow = u.pm < 16 ? 4 : ((u.pm - 16) >> 4);
        const float* gp = gate + (size_t)mrow * NMOD + col0;
        f32x4 gv[2][2];
#pragma unroll
        for (int bj = 0; bj < 2; ++bj)
#pragma unroll
            for (int n = 0; n < 2; ++n) gv[bj][n] = *(const f32x4*)(gp + bj * 128 + n * 4);
        if (u.ks) {
#pragma unroll
            for (int ai = 0; ai < 2; ++ai)
#pragma unroll
                for (int m = 0; m < 4; ++m) { bf16_t* prow = part + (size_t)(row0 + ai * 128 + m * 16 - 16384) * DM + col0;
#pragma unroll
                    for (int bj = 0; bj < 2; ++bj) { const f32x4 v0 = gv[bj][0] * acc[ai][bj][m][0], v1 = gv[bj][1] * acc[ai][bj][m][1];
                        u32x4 w; w.x = cvt_pk_bf16(v0[0], v0[1]); w.y = cvt_pk_bf16(v0[2], v0[3]); w.z = cvt_pk_bf16(v1[0], v1[1]); w.w = cvt_pk_bf16(v1[2], v1[3]);
                        *(u32x4*)(prow + bj * 128) = w; } }
            return;
        }
        f32x4 lg[2][2], lb[2][2];
#pragma unroll
        for (int bj = 0; bj < 2; ++bj)
#pragma unroll
            for (int n = 0; n < 2; ++n) { lg[bj][n] = *(const f32x4*)(g1 + col0 + bj * 128 + n * 4); lb[bj][n] = *(const f32x4*)(b1 + col0 + bj * 128 + n * 4); }
#pragma unroll
        for (int ai = 0; ai < 2; ++ai) {
            u32x4 pv[4][2]; float2 st[4];
#pragma unroll
            for (int m = 0; m < 4; ++m) { const int row = row0 + ai * 128 + m * 16;
                st[m] = *(const float2*)(stats + (size_t)row * 2);
#pragma unroll
                for (int bj = 0; bj < 2; ++bj) pv[m][bj] = *(const u32x4*)(pre1 + (size_t)row * DM + col0 + bj * 128); }
#pragma unroll
            for (int m = 0; m < 4; ++m) { bf16_t* orow = pre2 + (size_t)(row0 + ai * 128 + m * 16) * DM + col0;
                const float mu = st[m].x, rs = st[m].y;
#pragma unroll
                for (int bj = 0; bj < 2; ++bj) { const u32x4 p = pv[m][bj];
                    const f32x4 p0 = {bf_lo(p.x), bf_hi(p.x), bf_lo(p.y), bf_hi(p.y)}, p1 = {bf_lo(p.z), bf_hi(p.z), bf_lo(p.w), bf_hi(p.w)};
                    const f32x4 x0 = (p0 - mu) * rs * lg[bj][0] + lb[bj][0], x1 = (p1 - mu) * rs * lg[bj][1] + lb[bj][1];
                    const f32x4 v0 = x0 * ALPHA + gv[bj][0] * acc[ai][bj][m][0], v1 = x1 * ALPHA + gv[bj][1] * acc[ai][bj][m][1];
                    u32x4 w; w.x = cvt_pk_bf16(v0[0], v0[1]); w.y = cvt_pk_bf16(v0[2], v0[3]); w.z = cvt_pk_bf16(v1[0], v1[1]); w.w = cvt_pk_bf16(v1[2], v1[3]);
                    *(u32x4*)(orow + bj * 128) = w; } }
            asm volatile("" ::: "memory");
        }
    }
};
struct SplitOrder {
    int c;
    __device__ __forceinline__ bool next(int i, Unit& u) const {
        const int xcd = c & 7, offc = c >> 3;
        const bool rem = (i == 2);
        const int pmv = 4 * xcd + (offc & 3);
        const int ks = pmv >> 4;
        u.pm = rem ? 64 + (pmv & 15) : 8 * xcd + 4 * i + (offc & 3);
        u.pn = offc >> 2;
        u.ks = rem ? ks : 0; u.kt0 = rem ? ks * (DFF / 128) : 0; u.nkt = rem ? (DFF / 128) : (DFF / 64);
        return i <= 2;
    }
    __device__ __forceinline__ void a_ready(const Unit&) const {}
    __device__ __forceinline__ void done(const Unit&) const {}
};

template <bool TILED = false> __device__ __forceinline__ void transpose_piece(const float* __restrict__ W, int Krows, int Ncols, bf16_t* __restrict__ WT, int kt, int nt, int lane) {
    const int nq = lane >> 3, kg = lane & 7;
    const float* src = W + (size_t)(kt * 64 + kg * 8) * Ncols + nt * 32 + nq * 4;
    f32x4 r[8];
#pragma unroll
    for (int i = 0; i < 8; ++i) r[i] = __builtin_nontemporal_load((const f32x4*)(src + (size_t)i * Ncols));
    const int n0 = nt * 32 + nq * 4;
    bf16_t* dst = TILED ? WT + ((((size_t)(n0 >> 8) * (Krows / 64) + kt) * 256 + (n0 & 255)) * 64 + kg * 8) : WT + (size_t)n0 * Krows + kt * 64 + kg * 8;
    const size_t jstep = TILED ? 64 : (size_t)Krows;
#pragma unroll
    for (int j = 0; j < 4; ++j) { u32x4 w; w.x = cvt_pk_bf16(r[0][j], r[1][j]); w.y = cvt_pk_bf16(r[2][j], r[3][j]); w.z = cvt_pk_bf16(r[4][j], r[5][j]); w.w = cvt_pk_bf16(r[6][j], r[7][j]);
        *(u32x4*)(dst + (size_t)j * jstep) = w; }
}
constexpr int T_WIN = 32 * 80, T_WOUT = 32 * 64, T_FF1 = 32 * 256, T_FF2 = 128 * 64;
__device__ __forceinline__ void transpose_item(const Args& a, int it, int lane) {
    unsigned char* ws = a.ws;
    if (it < T_WIN) { transpose_piece<true>(a.in[I_WIN], DM, NIN, (bf16_t*)(ws + WS_WIN), it / 80, it % 80, lane); return; }
    it -= T_WIN;
    if (it < T_WOUT) { transpose_piece<true>(a.in[I_WOUT], DM, DM, (bf16_t*)(ws + WS_WOUT), it / 64, it % 64, lane); return; }
    it -= T_WOUT;
    if (it < T_FF1) { transpose_piece<true>(a.in[I_WFF1], DM, DFF, (bf16_t*)(ws + WS_WFF1), it / 256, it % 256, lane); return; }
    it -= T_FF1;
    if (it < T_FF2) { transpose_piece<true>(a.in[I_WFF2], DFF, DM, (bf16_t*)(ws + WS_WFF2), it / 64, it % 64, lane); return; }
    it -= T_FF2;
    { const int g = it >> 5, tt = it & 31; transpose_piece(a.in[I_WPOOL] + (size_t)g * 65536, 256, 256, (bf16_t*)(ws + WS_WPOOL) + (size_t)g * 65536, tt >> 3, tt & 7, lane); }
}
constexpr int N_TITEMS = 32 * 80 + 32 * 64 + 32 * 256 + 128 * 64 + 128;
__device__ __forceinline__ void mod_job(const Args& a, int job, float* __restrict__ mod, float* lds) {
    float* sil = lds; float* red = lds + 5 * DM;
    const int t = threadIdx.x;
    for (int i = t; i < 5 * DM; i += 512) { const float x = (i < 4 * DM) ? a.in[I_C][i] : a.in[I_CCTX][i - 4 * DM]; sil[i] = x / (1.f + __expf(-x)); }
    __syncthreads();
    const int cg4 = t & 15, ch = t >> 4, col0 = job * 64 + cg4 * 4;
    f32x4 a0 = {0.f, 0.f, 0.f, 0.f}, a1 = a0, a2 = a0, a3 = a0, a4 = a0;
    const float* wp = a.in[I_WMOD] + (size_t)(ch * 64) * NMOD + col0;
#pragma unroll 16
    for (int i = 0; i < 64; ++i) { const f32x4 w = __builtin_nontemporal_load((const f32x4*)(wp + (size_t)i * NMOD)); const int d = ch * 64 + i;
        a0 += w * sil[d]; a1 += w * sil[DM + d]; a2 += w * sil[2 * DM + d]; a3 += w * sil[3 * DM + d]; a4 += w * sil[4 * DM + d]; }
    *(f32x4*)(red + (ch * 5 + 0) * 64 + cg4 * 4) = a0; *(f32x4*)(red + (ch * 5 + 1) * 64 + cg4 * 4) = a1; *(f32x4*)(red + (ch * 5 + 2) * 64 + cg4 * 4) = a2;
    *(f32x4*)(red + (ch * 5 + 3) * 64 + cg4 * 4) = a3; *(f32x4*)(red + (ch * 5 + 4) * 64 + cg4 * 4) = a4;
    __syncthreads();
    if (t < 320) { const int r = t >> 6, col = t & 63; float s = 0.f;
#pragma unroll 8
        for (int c = 0; c < 32; ++c) s += red[(c * 5 + r) * 64 + col];
        mod[(size_t)r * NMOD + job * 64 + col] = s + a.in[I_BMOD][job * 64 + col]; }
    __syncthreads();
}
__device__ __forceinline__ void slack_transposes(const Args& a, int lo, int hi, int first_wg) {
    int tid_l = threadIdx.x; asm volatile("" : "+v"(tid_l));
    const int lane = tid_l & 63, wid = tid_l >> 6, bid = blockIdx.x;
    if (bid < first_wg) return;
    for (int it = lo + (bid - first_wg) * 8 + wid; it < hi; it += (256 - first_wg) * 8) transpose_item(a, it, lane);
}
__device__ void phase_prep(const Args& a, float* lds) {
    unsigned char* ws = a.ws;
    float* mod = (float*)(ws + WS_MOD);
    int tid_l = threadIdx.x; asm volatile("" : "+v"(tid_l));
    const int lane = tid_l & 63, wid = tid_l >> 6, G = gridDim.x, bid = blockIdx.x;
    constexpr int J_MOD = NMOD / 64;
    if (G == 256) {
        if (bid < J_MOD) mod_job(a, bid, mod, lds);
        else { for (int it = (bid - J_MOD) * 8 + wid; it < T_WIN; it += 64 * 8) transpose_item(a, it, lane);
               for (int it = N_TITEMS - 128 + (bid - J_MOD) * 8 + wid; it < N_TITEMS; it += 64 * 8) transpose_item(a, it, lane); }
    } else {
        for (int job = bid; job < J_MOD; job += G) mod_job(a, job, mod, lds);
        for (int it = bid * 8 + wid; it < N_TITEMS; it += G * 8) transpose_item(a, it, lane);
    }
    bf16_t* klat = (bf16_t*)(ws + WS_KLAT); bf16_t* vlat = (bf16_t*)(ws + WS_VLAT);
    constexpr int NC8 = 4 * 512 * 256 / 8;
    for (int i = bid * 512 + tid_l; i < 2 * NC8; i += G * 512) {
        const bool isk = i < NC8; const int e = (isk ? i : i - NC8) * 8;
        const float* src = (isk ? a.in[I_CK] : a.in[I_CV]) + e;
        const f32x4 v0 = *(const f32x4*)src, v1 = *(const f32x4*)(src + 4);
        const int b = e / (512 * 256), rem = e % (512 * 256);
        bf16_t* dst = (isk ? klat : vlat) + (size_t)b * SKV_LAT * 256 + rem;
        u32x4 w; w.x = cvt_pk_bf16(v0[0], v0[1]); w.y = cvt_pk_bf16(v0[2], v0[3]); w.z = cvt_pk_bf16(v1[0], v1[1]); w.w = cvt_pk_bf16(v1[2], v1[3]);
        *(u32x4*)dst = w;
    }
    float* ropeC = (float*)(ws + WS_ROPE); float* ropeS = ropeC + 2048;
    for (int i = bid * 512 + tid_l; i < 2048; i += G * 512) { const int pos = i >> 5, fi = i & 31;
        const float inv = exp2f(-(float)fi * (13.287712379549449f / 32.f)); const float ang = (float)pos * inv;
        ropeC[i] = cosf(ang); ropeS[i] = sinf(ang); }
}

__device__ __forceinline__ void row_stats(const f32x4 (&v)[8], float& mu, float& rstd) {
    float s = 0.f;
#pragma unroll
    for (int i = 0; i < 8; ++i) s += (v[i][0] + v[i][1]) + (v[i][2] + v[i][3]);
    s = wave_sum(s); mu = s * (1.f / DM);
    float q = 0.f;
#pragma unroll
    for (int i = 0; i < 8; ++i) { const f32x4 d = v[i] - mu; q += (d[0] * d[0] + d[1] * d[1]) + (d[2] * d[2] + d[3] * d[3]); }
    q = wave_sum(q); rstd = 1.0f / sqrtf(q * (1.f / DM) + LN_EPS);
}
#define LD8(dst, p) do { _Pragma("unroll") for (int _i = 0; _i < 8; ++_i) dst[_i] = *(const f32x4*)((p) + _i * 256 + lane * 4); } while (0)
__device__ __forceinline__ void ln_in_row(const f32x4 (&v)[8], const f32x4 (&sh)[8], const f32x4 (&sc)[8], bf16_t* __restrict__ U, int row, int lane) {
    float mu, rstd; row_stats(v, mu, rstd);
#pragma unroll
    for (int i = 0; i < 8; ++i) { const int col = i * 256 + lane * 4;
        const f32x4 o = (v[i] - mu) * rstd * (sc[i] + 1.0f) + sh[i];
        u32x2 w; w.x = cvt_pk_bf16(o[0], o[1]); w.y = cvt_pk_bf16(o[2], o[3]);
        *(u32x2*)(U + tiled_off(row, col, DM / 64)) = w; }
}
__device__ void phase_ln_in(const Args& a) {
    int tid_l = threadIdx.x; asm volatile("" : "+v"(tid_l));
    const int lane = tid_l & 63, wid = tid_l >> 6;
    const float* __restrict__ mod = (const float*)(a.ws + WS_MOD); bf16_t* __restrict__ U = (bf16_t*)(a.ws + WS_ACT);
    const int stride = gridDim.x * 8; int row = blockIdx.x * 8 + wid;
    f32x4 nx0[8], nx1[8];
    if (row < MTOT) { LD8(nx0, x_row(a, row)); LD8(nx1, x_row(a, min(row + stride, MTOT - 1))); }
    for (; row < MTOT; row += 2 * stride) {
        const int row1 = row + stride;
        f32x4 v0[8], v1[8], sh[8], sc[8];
        const int mr0 = mod_row_of(row);
        { const float* mp = mod + (size_t)mr0 * NMOD; LD8(sh, mp); LD8(sc, mp + DM); }
#pragma unroll
        for (int i = 0; i < 8; ++i) { v0[i] = nx0[i]; v1[i] = nx1[i]; }
        LD8(nx0, x_row(a, min(row + 2 * stride, MTOT - 1))); LD8(nx1, x_row(a, min(row + 3 * stride, MTOT - 1)));
        ln_in_row(v0, sh, sc, U, row, lane);
        if (row1 < MTOT) {
            const int mr1 = mod_row_of(row1);
            if (mr1 != mr0) { const float* mp = mod + (size_t)mr1 * NMOD; LD8(sh, mp); LD8(sc, mp + DM); }
            ln_in_row(v1, sh, sc, U, row1, lane);
        }
    }
}
__device__ __forceinline__ void ld_row_bf16(const bf16_t* __restrict__ p, int lane, u32x4 (&w)[4]) {
#pragma unroll
    for (int i = 0; i < 4; ++i) w[i] = *(const u32x4*)(p + i * 512 + lane * 8);
}
__device__ __forceinline__ void unpack_row(const u32x4 (&w)[4], float (&v)[32]) {
#pragma unroll
    for (int i = 0; i < 4; ++i) { v[8 * i + 0] = bf_lo(w[i].x); v[8 * i + 1] = bf_hi(w[i].x); v[8 * i + 2] = bf_lo(w[i].y); v[8 * i + 3] = bf_hi(w[i].y);
        v[8 * i + 4] = bf_lo(w[i].z); v[8 * i + 5] = bf_hi(w[i].z); v[8 * i + 6] = bf_lo(w[i].w); v[8 * i + 7] = bf_hi(w[i].w); }
}
__device__ __forceinline__ void ld_vec32(const float* __restrict__ p, int lane, float (&g)[32]) {
#pragma unroll
    for (int i = 0; i < 4; ++i) { const f32x4 a = *(const f32x4*)(p + i * 512 + lane * 8), b = *(const f32x4*)(p + i * 512 + lane * 8 + 4);
#pragma unroll
        for (int e = 0; e < 4; ++e) { g[8 * i + e] = a[e]; g[8 * i + 4 + e] = b[e]; } }
}
__device__ __forceinline__ void stats32(const float (&v)[32], float& mu, float& rstd) {
    float s = 0.f;
#pragma unroll
    for (int i = 0; i < 32; ++i) s += v[i];
    s = wave_sum(s); mu = s * (1.f / DM);
    float q = 0.f;
#pragma unroll
    for (int i = 0; i < 32; ++i) { const float d = v[i] - mu; q += d * d; }
    q = wave_sum(q); rstd = 1.0f / sqrtf(q * (1.f / DM) + LN_EPS);
}
__device__ __forceinline__ void ln_mid_row(const u32x4 (&raw)[4], const float (&g)[32], const float (&b)[32], const float (&sh)[32], const float (&sc)[32], float* __restrict__ st, bf16_t* __restrict__ U, int row, int lane) {
    float v[32]; unpack_row(raw, v);
    float mu, rstd; stats32(v, mu, rstd);
    if (lane == 0) { float2 s2; s2.x = mu; s2.y = rstd; *(float2*)st = s2; }
#pragma unroll
    for (int i = 0; i < 32; ++i) v[i] = (v[i] - mu) * rstd * g[i] + b[i];
    float mu2, rstd2; stats32(v, mu2, rstd2);
#pragma unroll
    for (int i = 0; i < 4; ++i) { float o[8];
#pragma unroll
        for (int e = 0; e < 8; ++e) o[e] = (v[8 * i + e] - mu2) * rstd2 * (sc[8 * i + e] + 1.0f) + sh[8 * i + e];
        u32x4 w; w.x = cvt_pk_bf16(o[0], o[1]); w.y = cvt_pk_bf16(o[2], o[3]); w.z = cvt_pk_bf16(o[4], o[5]); w.w = cvt_pk_bf16(o[6], o[7]);
        *(u32x4*)(U + tiled_off(row, i * 512 + lane * 8, DM / 64)) = w; }
}
__device__ void phase_ln_mid(const Args& a) {
    int tid_l = threadIdx.x; asm volatile("" : "+v"(tid_l));
    const int lane = tid_l & 63, wid = tid_l >> 6;
    const float* __restrict__ mod = (const float*)(a.ws + WS_MOD); bf16_t* __restrict__ U = (bf16_t*)(a.ws + WS_ACT);
    const bf16_t* __restrict__ pre1 = (const bf16_t*)a.out; float* __restrict__ stats = (float*)(a.ws + WS_STATS);
    const int stride = gridDim.x * 8; int row = blockIdx.x * 8 + wid;
    float g[32], b[32]; ld_vec32(a.in[I_LN1G], lane, g); ld_vec32(a.in[I_LN1B], lane, b);
    u32x4 nx0[4], nx1[4];
    if (row < MTOT) { ld_row_bf16(pre1 + (size_t)row * DM, lane, nx0); ld_row_bf16(pre1 + (size_t)min(row + stride, MTOT - 1) * DM, lane, nx1); }
    for (; row < MTOT; row += 2 * stride) {
        const int row1 = row + stride;
        float sh[32], sc[32];
        const int mr0 = mod_row_of(row);
        { const float* mp = mod + (size_t)mr0 * NMOD + 3 * DM; ld_vec32(mp, lane, sh); ld_vec32(mp + DM, lane, sc); }
        u32x4 c0[4], c1[4];
#pragma unroll
        for (int i = 0; i < 4; ++i) { c0[i] = nx0[i]; c1[i] = nx1[i]; }
        ld_row_bf16(pre1 + (size_t)min(row + 2 * stride, MTOT - 1) * DM, lane, nx0); ld_row_bf16(pre1 + (size_t)min(row + 3 * stride, MTOT - 1) * DM, lane, nx1);
        ln_mid_row(c0, g, b, sh, sc, stats + (size_t)row * 2, U, row, lane);
        if (row1 < MTOT) {
            const int mr1 = mod_row_of(row1);
            if (mr1 != mr0) { const float* mp = mod + (size_t)mr1 * NMOD + 3 * DM; ld_vec32(mp, lane, sh); ld_vec32(mp + DM, lane, sc); }
            ln_mid_row(c1, g, b, sh, sc, stats + (size_t)row1 * 2, U, row1, lane);
        }
    }
}
__device__ __forceinline__ void ln_out_row(const u32x4 (&raw)[4], const u32x4 (&praw)[4], bool has_part, const float (&g)[32], const float (&b)[32], float* __restrict__ orow, int lane) {
    float v[32]; unpack_row(raw, v);
    if (has_part) { float pp[32]; unpack_row(praw, pp);
#pragma unroll
        for (int i = 0; i < 32; ++i) v[i] += pp[i]; }
    float mu, rstd; stats32(v, mu, rstd);
#pragma unroll
    for (int i = 0; i < 4; ++i) { f32x4 o0, o1;
#pragma unroll
        for (int e = 0; e < 4; ++e) { o0[e] = (v[8 * i + e] - mu) * rstd * g[8 * i + e] + b[8 * i + e]; o1[e] = (v[8 * i + 4 + e] - mu) * rstd * g[8 * i + 4 + e] + b[8 * i + 4 + e]; }
        float* op = orow + i * 512 + lane * 8;
        *(f32x4*)op = o0; *(f32x4*)(op + 4) = o1; }
}
__device__ void phase_ln_out(const Args& a, const bf16_t* __restrict__ pre2, const bf16_t* __restrict__ part) {
    int tid_l = threadIdx.x; asm volatile("" : "+v"(tid_l));
    const int lane = tid_l & 63, wid = tid_l >> 6;
    float* __restrict__ out = a.out;
    const int stride = gridDim.x * 8; int row = blockIdx.x * 8 + wid;
    float g[32], b[32]; ld_vec32(a.in[I_LN2G], lane, g); ld_vec32(a.in[I_LN2B], lane, b);
    u32x4 nx0[4], nx1[4], np0[4], np1[4];
#pragma unroll
    for (int i = 0; i < 4; ++i) { np0[i] = (u32x4){0u, 0u, 0u, 0u}; np1[i] = np0[i]; }
#define LDROWP(nx, np, r) do { const int r_ = min((r), MTOT - 1); ld_row_bf16(pre2 + (size_t)r_ * DM, lane, nx); if (part && r_ >= 16384) ld_row_bf16(part + (size_t)(r_ - 16384) * DM, lane, np); } while (0)
    if (row < MTOT) { LDROWP(nx0, np0, row); LDROWP(nx1, np1, row + stride); }
    for (; row < MTOT; row += 2 * stride) {
        const int row1 = row + stride;
        u32x4 c0[4], c1[4], p0[4], p1[4];
#pragma unroll
        for (int i = 0; i < 4; ++i) { c0[i] = nx0[i]; c1[i] = nx1[i]; p0[i] = np0[i]; p1[i] = np1[i]; }
        LDROWP(nx0, np0, row + 2 * stride); LDROWP(nx1, np1, row + 3 * stride);
        ln_out_row(c0, p0, part && row >= 16384, g, b, out + (size_t)row * DM, lane);
        if (row1 < MTOT) ln_out_row(c1, p1, part && row1 >= 16384, g, b, out + (size_t)row1 * DM, lane);
    }
#undef LDROWP
}

__device__ __forceinline__ float row16_sum(float v) { v += dpp_f<0xB1>(v); v += dpp_f<0x4E>(v); v += dpp_f<0x141>(v); v += dpp_f<0x140>(v); return v; }
__device__ __forceinline__ float lane_xor4(float v) { return dpp_f<0x1B>(dpp_f<0x141>(v)); }
__device__ __forceinline__ void unpack8(const u32x4 w, float (&x)[8]) { x[0] = bf_lo(w.x); x[1] = bf_hi(w.x); x[2] = bf_lo(w.y); x[3] = bf_hi(w.y); x[4] = bf_lo(w.z); x[5] = bf_hi(w.z); x[6] = bf_lo(w.w); x[7] = bf_hi(w.w); }
__device__ __forceinline__ u32x4 pack8(const float (&x)[8]) { u32x4 w; w.x = cvt_pk_bf16(x[0], x[1]); w.y = cvt_pk_bf16(x[2], x[3]); w.z = cvt_pk_bf16(x[4], x[5]); w.w = cvt_pk_bf16(x[6], x[7]); return w; }
__device__ __forceinline__ void norm_rope8(float (&x)[8], const float (&gn)[8], const float (&cs)[8], const float (&sn)[8], bool lat) {
    float ss = 0.f;
#pragma unroll
    for (int e = 0; e < 8; ++e) ss += x[e] * x[e];
    ss = row16_sum(ss); const float rinv = 1.0f / sqrtf(ss * (1.f / 128.f) + LN_EPS);
#pragma unroll
    for (int e = 0; e < 8; ++e) x[e] = x[e] * rinv * gn[e];
    if (lat) {
#pragma unroll
        for (int e = 0; e < 8; ++e) { const float p = lane_xor4(x[e]); x[e] = x[e] * cs[e] + p * sn[e]; } }
}
__device__ void phase_elem(const Args& a) {
    int tid_l = threadIdx.x; asm volatile("" : "+v"(tid_l));
    const int lane = tid_l & 63, wid = tid_l >> 6;
    unsigned char* ws = a.ws;
    const bf16_t* __restrict__ PROJ = (const bf16_t*)(ws + WS_PROJ);
    bf16_t* __restrict__ KL = (bf16_t*)(ws + WS_KLAT); bf16_t* __restrict__ VL = (bf16_t*)(ws + WS_VLAT);
    bf16_t* __restrict__ KC = (bf16_t*)(ws + WS_KCTX); bf16_t* __restrict__ VC = (bf16_t*)(ws + WS_VCTX);
    const float* __restrict__ ropeC = (const float*)(ws + WS_ROPE); const float* __restrict__ ropeS = ropeC + 2048;
    float* __restrict__ ctxk = a.out + (size_t)MTOT * DM; float* __restrict__ ctxv = ctxk + (size_t)MCTX * 256;
    const int j16 = lane & 15; const bool colpart = j16 >= 8, second = (j16 & 4) != 0; const int f0 = 8 * (j16 & 3);
    float kg[8];
#pragma unroll
    for (int e = 0; e < 8; ++e) kg[e] = a.in[I_KG][8 * j16 + e];
    const int stride = gridDim.x * 8;
    for (int base = blockIdx.x * 8 + wid; base < MTOT; base += 5 * stride) {
        u32x4 c2[5]; f32x4 ca[5], cb[5], sa[5], sb[5];
#pragma unroll
        for (int k = 0; k < 5; ++k) { const int tk = min(base + k * stride, MTOT - 1);
            c2[k] = *(const u32x4*)(PROJ + (size_t)tk * NIN + 1024 + lane * 8);
            const bool latk = tk >= MCTX; const int sk = (tk - MCTX) & 4095;
            const int pos = latk ? (colpart ? (sk & 63) : (sk >> 6)) : 0;
            ca[k] = *(const f32x4*)(ropeC + pos * 32 + f0); cb[k] = *(const f32x4*)(ropeC + pos * 32 + f0 + 4); sa[k] = *(const f32x4*)(ropeS + pos * 32 + f0); sb[k] = *(const f32x4*)(ropeS + pos * 32 + f0 + 4); }
#pragma unroll
        for (int k = 0; k < 5; ++k) { const int tok = base + k * stride;
            if (tok < MTOT) {
                const bool lat = tok >= MCTX;
                int b, s; if (!lat) { b = tok >> 8; s = tok & 255; } else { const int tt = tok - MCTX; b = tt >> 12; s = tt & 4095; }
                float cs[8], sn[8];
#pragma unroll
                for (int e = 0; e < 4; ++e) { cs[e] = ca[k][e]; cs[4 + e] = cb[k][e]; sn[e] = second ? sa[k][e] : -sa[k][e]; sn[4 + e] = second ? sb[k][e] : -sb[k][e]; }
                float x2[8]; unpack8(c2[k], x2);
                float x2n[8];
#pragma unroll
                for (int e = 0; e < 8; ++e) x2n[e] = x2[e];
                norm_rope8(x2n, kg, cs, sn, lat);
                const bool isk = lane < 32;
                float kv[8];
#pragma unroll
                for (int e = 0; e < 8; ++e) kv[e] = isk ? x2n[e] : x2[e];
                const u32x4 kvw = pack8(kv);
                const int off = (lane & 31) * 8;
                if (lat) { bf16_t* dst = (isk ? KL : VL) + ((size_t)b * SKV_LAT + 512 + s) * 256 + off; *(u32x4*)dst = kvw; }
                else { bf16_t* dst = (isk ? KC : VC) + (size_t)tok * 256 + off; *(u32x4*)dst = kvw;
                    float* fo = (isk ? ctxk : ctxv) + (size_t)tok * 256 + off;
                    *(f32x4*)fo = (f32x4){kv[0], kv[1], kv[2], kv[3]}; *(f32x4*)(fo + 4) = (f32x4){kv[4], kv[5], kv[6], kv[7]}; }
            } }
    }
}
__device__ __forceinline__ void add8(float (&acc)[8], const u32x4 w, float wgt) {
    acc[0] += wgt * bf_lo(w.x); acc[1] += wgt * bf_hi(w.x); acc[2] += wgt * bf_lo(w.y); acc[3] += wgt * bf_hi(w.y);
    acc[4] += wgt * bf_lo(w.z); acc[5] += wgt * bf_hi(w.z); acc[6] += wgt * bf_lo(w.w); acc[7] += wgt * bf_hi(w.w);
}
__device__ __forceinline__ void seq_bounds(int t, int& sb, int& se) { if (t < MCTX) { sb = t & ~255; se = sb + 256; } else { sb = MCTX + ((t - MCTX) & ~4095); se = sb + 4096; } }
__device__ __forceinline__ void window_init(const bf16_t* __restrict__ pb, int cur, int half, float (&acc)[8]) {
    int sb, se; seq_bounds(cur, sb, se);
#pragma unroll
    for (int e = 0; e < 8; ++e) acc[e] = 0.f;
    for (int i = 0; i < 2 * half; ++i) { const int r = cur - half + i; const float wgt = (r >= sb && r < se) ? 1.f : 0.f; const int rc = min(max(r, sb), se - 1);
        add8(acc, *(const u32x4*)(pb + (size_t)rc * NIN), wgt); }
}
__device__ void phase_pooled(const Args& a) {
    int tid_l = threadIdx.x; asm volatile("" : "+v"(tid_l));
    const bf16_t* __restrict__ PROJ = (const bf16_t*)(a.ws + WS_PROJ); bf16_t* __restrict__ PO = (bf16_t*)(a.ws + WS_POOLED);
    constexpr int RUN = 20, NITEM = (MTOT / RUN) * 128;
    for (int item = blockIdx.x * 512 + tid_l; item < NITEM; item += gridDim.x * 512) {
        const int run = item >> 7, oct = item & 127, half = 1 << (oct >> 5);
        const int r0 = run * RUN;
        const bf16_t* pb = PROJ + 1536 + 8 * oct;
        bf16_t* ob = PO + 8 * oct;
        float acc[8];
        window_init(pb, r0, half, acc);
#pragma unroll 4
        for (int j = 0; j < RUN; ++j) {
            const int cur = r0 + j;
            int sb, se; seq_bounds(cur, sb, se);
            const int lo = max(cur - half, sb), hi = min(cur + half, se);
            const u32x4 self = *(const u32x4*)(pb + (size_t)cur * NIN);
            const int rin = cur + half, rout = cur - half;
            const u32x4 win = *(const u32x4*)(pb + (size_t)min(rin, se - 1) * NIN), wout = *(const u32x4*)(pb + (size_t)max(rout, sb) * NIN);
            const float ic = 1.0f / (float)(hi - lo);
            float sv[8]; unpack8(self, sv);
            float o[8];
#pragma unroll
            for (int e = 0; e < 8; ++e) o[e] = acc[e] * ic - sv[e];
            *(u32x4*)(ob + (size_t)cur * 1024) = pack8(o);
            if (cur + 1 < se) { add8(acc, win, rin < se ? 1.f : 0.f); add8(acc, wout, rout >= sb ? -1.f : 0.f); }
            else if (j + 1 < RUN) window_init(pb, cur + 1, half, acc);
        }
    }
}

typedef const Args __attribute__((address_space(4)))* KArgsP;
__device__ __forceinline__ Args load_args() {
    Args r;
#if defined(__HIP_DEVICE_COMPILE__)
    KArgsP p = (KArgsP)__builtin_amdgcn_kernarg_segment_ptr(); asm volatile("" : "+s"(p));
#pragma unroll
    for (int i = 0; i < 20; ++i) r.in[i] = p->in[i];
    r.out = p->out; r.ws = p->ws;
#endif
    return r;
}
__device__ __forceinline__ int grid_size() { int g = (int)gridDim.x; asm volatile("" : "+s"(g)); return g; }
#define SEAM() do { XcdBarrier xb_; { unsigned* bp_ = (unsigned*)(load_args().ws + WS_BAR); asm volatile("" : "+s"(bp_)); xb_.bar = bp_; } xb_.x = xb_xcc_id(); \
    xb_.st = (volatile LAS unsigned*)((PG8_LAS unsigned char*)shm + 131072); xcd_barrier(xb_); } while (0)
#ifndef REP_P0
#define REP_P0 1
#endif
#ifndef REP_P3B
#define REP_P3B 1
#endif
#ifndef REP_P6
#define REP_P6 1
#endif
__global__ void __launch_bounds__(512, 2) mega_fwd(Args a_unused) {
    extern __shared__ __attribute__((aligned(16))) unsigned char shm[];
    PG8_LAS unsigned char* lds3 = (PG8_LAS unsigned char*)shm;
    const int bid = blockIdx.x;

    { const Args a = load_args(); const int G = grid_size(); (void)G;
      unsigned* barw = (unsigned*)(a.ws + WS_BAR);
      volatile LAS unsigned* bst = (volatile LAS unsigned*)(lds3 + 131072);
      if (bid == 0) for (int i = threadIdx.x; i < XCD_BAR_WORDS; i += 512) barw[i] = 0u;
      if (threadIdx.x == 0) { bst[0] = 0u; bst[1] = 0u; }
      for (int rep = 0; rep < REP_P0; ++rep) phase_prep(a, (float*)shm);
      cg::this_grid().sync();
      (void)xcd_barrier_post(barw, bst); }
    { const Args a = load_args(); const int G = grid_size(); (void)G; phase_ln_in(a); }
    SEAM();
    { const Args a = load_args(); const int G = grid_size(); (void)G; unsigned char* ws = a.ws;
      pg8::Gemm g{(const bf16_t*)(ws + WS_ACT), (const bf16_t*)(ws + WS_WIN), MTOT, NIN, DM, 64, 64, 0}; pg8::StaticOrder S; S.init(MTOT, NIN, G, bid);
      EpiB<0, false> E{(bf16_t*)(ws + WS_PROJ), NIN, nullptr, 0, 0};
      pg8::gemm_phase<EpiB<0, false>, pg8::StaticOrder, true>(lds3, g, S, E, nullptr);
      if (G == 256) slack_transposes(a, T_WIN, T_WIN + T_WOUT + T_FF1 + T_FF2 / 2, 32); }
    SEAM();
    { const Args a = load_args(); const int G = grid_size(); (void)G; phase_elem(a); phase_pooled(a); }
    SEAM();
    for (int rep = 0; rep < REP_P3B; ++rep) {
        const Args a = load_args(); const int G = grid_size(); (void)G; unsigned char* ws = a.ws;
        const att::bf16* Qb = (const att::bf16*)(ws + WS_PROJ); bf16_t* ACT = (bf16_t*)(ws + WS_ACT);
        for (int u = bid; u < 640; u += G) {
            const bool lat = u < 512; const int uu = lat ? u : u - 512;
            const int h = lat ? ((uu >> 4) & 7) : (uu & 7), b = lat ? (uu >> 7) : (uu >> 3);
            const size_t tok0 = lat ? ((size_t)MCTX + (size_t)b * 4096 + (uu & 15) * 256) : (size_t)b * 256;
            const size_t kvoff = (lat ? (size_t)b * SKV_LAT * 256 : tok0 * 256) + (h >> 2) * 128;
            const att::bf16* Kh = (const att::bf16*)(ws + (lat ? WS_KLAT : WS_KCTX)) + kvoff;
            const att::bf16* Vh = (const att::bf16*)(ws + (lat ? WS_VLAT : WS_VCTX)) + kvoff;
            __syncthreads();
            att::attn_dense_body<att::bf16>(Qb + tok0 * NIN + h * 128, Kh, Vh, ACT, (int)tok0, h * 128, lat ? SKV_LAT : 256, (char*)shm,
                                            a.in[I_QG], (const float*)(ws + WS_ROPE), (const float*)(ws + WS_ROPE) + 2048, lat ? (uu & 15) * 256 : 0, lat);
        }
        __syncthreads();
        pg8::Gemm g{(const bf16_t*)(ws + WS_POOLED), (const bf16_t*)(ws + WS_WPOOL), MTOT, 1024, 256, 1024, 256, 512}; pg8::StaticOrder S; S.init(MTOT, 1024, G, (bid + G / 2) % G);
        EpiB<0, true> E{ACT, DM, a.in[I_PSCALE], DM / 64, 1024};
        pg8::gemm_phase<EpiB<0, true>, pg8::StaticOrder>(lds3, g, S, E, nullptr);
    }
    SEAM();
    { const Args a = load_args(); const int G = grid_size(); (void)G; unsigned char* ws = a.ws;
      pg8::Gemm g{(const bf16_t*)(ws + WS_ACT), (const bf16_t*)(ws + WS_WOUT), MTOT, DM, DM, 64, 64, 0}; pg8::StaticOrder S; S.init(MTOT, DM, G, bid);
      EpiPre1 E{a.in[I_XP], a.in[I_XS], (bf16_t*)a.out, (const float*)(ws + WS_MOD) + 2 * DM};
      pg8::gemm_phase<EpiPre1, pg8::StaticOrder, true>(lds3, g, S, E, nullptr);
      if (G == 256) slack_transposes(a, T_WIN + T_WOUT + T_FF1 + T_FF2 / 2, T_WIN + T_WOUT + T_FF1 + T_FF2, 128); }
    SEAM();
    { const Args a = load_args(); const int G = grid_size(); (void)G; phase_ln_mid(a); }
    SEAM();
    for (int rep = 0; rep < REP_P6; ++rep) { const Args a = load_args(); const int G = grid_size(); (void)G; unsigned char* ws = a.ws;
      pg8::Gemm g{(const bf16_t*)(ws + WS_ACT), (const bf16_t*)(ws + WS_WFF1), MTOT, DFF, DM, 64, 64, 0}; pg8::StaticOrder S; S.init(MTOT, DFF, G, bid);
      EpiB<1, false> E{(bf16_t*)(ws + WS_H), DFF, nullptr, DFF / 64, 0};
      pg8::gemm_phase<EpiB<1, false>, pg8::StaticOrder, true>(lds3, g, S, E, nullptr); }
    SEAM();
    { const Args a = load_args(); const int G = grid_size(); (void)G; unsigned char* ws = a.ws;
      pg8::Gemm g{(const bf16_t*)(ws + WS_H), (const bf16_t*)(ws + WS_WFF2), MTOT, DM, DFF, 64, 64, 0};
      EpiPre2 E{(const bf16_t*)a.out, (const float*)(ws + WS_STATS), a.in[I_LN1G], a.in[I_LN1B], (bf16_t*)(ws + WS_ACT), (const float*)(ws + WS_MOD) + 5 * DM, (bf16_t*)(ws + WS_PART)};
      if (G == 256) { SplitOrder S; S.c = bid; pg8::gemm_phase<EpiPre2, SplitOrder, true>(lds3, g, S, E, nullptr); }
      else { pg8::StaticOrder S; S.init(MTOT, DM, G, bid); pg8::gemm_phase<EpiPre2, pg8::StaticOrder, true>(lds3, g, S, E, nullptr); } }
    SEAM();
    { const Args a = load_args(); const int G = grid_size(); (void)G; phase_ln_out(a, (const bf16_t*)(a.ws + WS_ACT), G == 256 ? (const bf16_t*)(a.ws + WS_PART) : nullptr); }
}

extern "C" void kernel_launch(void* const* d_in, const int* in_sizes, int n_in, void* d_out, int out_size, void* d_ws, size_t ws_size, hipStream_t stream) {
    static int grid = 0;
    if (grid == 0) {
        if (n_in != 20 || ws_size < WS_END) { fprintf(stderr, "kernel_launch: need 20 inputs and %zu bytes of workspace (got %d, %zu)\n", (size_t)WS_END, n_in, ws_size); grid = -1; return; }
        int dev = 0, cus = 0, per_cu = 0;
        hipGetDevice(&dev); hipDeviceGetAttribute(&cus, hipDeviceAttributeMultiprocessorCount, dev);
        if (hipFuncSetAttribute((const void*)mega_fwd, hipFuncAttributeMaxDynamicSharedMemorySize, LDS_BYTES) != hipSuccess) { fprintf(stderr, "kernel_launch: hipFuncSetAttribute failed\n"); grid = -1; return; }
        if (hipOccupancyMaxActiveBlocksPerMultiprocessor(&per_cu, (const void*)mega_fwd, 512, LDS_BYTES) != hipSuccess || per_cu < 1) { fprintf(stderr, "kernel_launch: occupancy query says %d\n", per_cu); per_cu = 1; }
        (void)hipGetLastError();
        grid = cus * 1;
    }
    if (grid < 0) return;
    Args a{};
    for (int i = 0; i < 20; ++i) a.in[i] = (const float*)d_in[i];
    a.out = (float*)d_out; a.ws = (unsigned char*)d_ws;
    void* args[] = {&a};
    hipError_t e = hipLaunchCooperativeKernel((const void*)mega_fwd, dim3(grid), dim3(512), args, LDS_BYTES, stream);
    if (e != hipSuccess) fprintf(stderr, "kernel_launch: cooperative launch failed: %s (grid %d)\n", hipGetErrorString(e), grid);
}
```
